# Optimizing an MI355X kernel written in HIP

```python
import math
import jax, jax.numpy as jnp
from jax import lax
import numpy as np

D_MODEL = 1024
BATCH = 4
SEQ = 4096
DEPTH = 2

HEAD_DIM = 64
DIFF_HEADS = D_MODEL // (4 * HEAD_DIM)
FOX_HEADS = D_MODEL // (2 * HEAD_DIM)
DIFF_QK = DIFF_HEADS * 2 * HEAD_DIM
DIFF_V = DIFF_HEADS * 2 * HEAD_DIM
FOX_QK = FOX_HEADS * HEAD_DIM
FOX_V = FOX_HEADS * HEAD_DIM
ATTN_IN_SPLIT = (DIFF_QK, DIFF_QK, DIFF_V, FOX_QK, FOX_QK, FOX_V, FOX_HEADS)
ATTN_IN_WIDTH = sum(ATTN_IN_SPLIT)
ATTN_OUT_WIDTH = DIFF_V + FOX_V
Q_BLOCK = 128
FORGET_BIAS_INIT = 3.0
RNN_BLOCK_W = 128
RNN_WIDTH = (4 * D_MODEL // 3) // RNN_BLOCK_W * RNN_BLOCK_W
RNN_BLOCKS = RNN_WIDTH // RNN_BLOCK_W
CONV_WIDTH = 4
RG_C = 8.0
D_FF = 4 * D_MODEL
PLE_DIM = 256
N_ATTN_LAYERS = (DEPTH + 1) // 2
N_REC_LAYERS = DEPTH // 2
NORM_EPS = 1e-6
SUBLN_EPS = 1e-5

kernel_name = "hybrid_diff_fox_rglru_block"


def rmsnorm(x, gain, eps=NORM_EPS):
    xf = x.astype(jnp.float32)
    y = xf * lax.rsqrt(jnp.mean(xf * xf, axis=-1, keepdims=True) + eps)
    return (y * gain.astype(jnp.float32)).astype(x.dtype)


def alibi_slopes(n_heads):
    return jnp.exp2(-8.0 * jnp.arange(1, n_heads + 1, dtype=jnp.float32) / n_heads)


def sweep_query_blocks(block_fn, batch, seq):
    out = lax.map(block_fn, jnp.arange(seq // Q_BLOCK))
    return jnp.moveaxis(out, 0, 1).reshape(batch, seq, out.shape[3], out.shape[4])


def differential_attention(q, k, v, lam):
    B, S, H, _, Dh = q.shape
    qf = q.astype(jnp.float32) * (Dh ** -0.5)
    kf = k.astype(jnp.float32)
    vf = v.astype(jnp.float32)
    slopes = alibi_slopes(H)
    kpos = jnp.arange(S)

    def block(i):
        qb = lax.dynamic_slice_in_dim(qf, i * Q_BLOCK, Q_BLOCK, axis=1)
        qpos = i * Q_BLOCK + jnp.arange(Q_BLOCK)
        s = jnp.einsum('bqhmd,bkhmd->bhmqk', qb, kf)
        dist = (qpos[:, None] - kpos[None, :]).astype(jnp.float32)
        s = s - (slopes[:, None, None] * dist)[None, :, None]
        causal = kpos[None, :] <= qpos[:, None]
        s = jnp.where(causal[None, None, None], s, -jnp.inf)
        pr = jax.nn.softmax(s, axis=-1)
        w = pr[:, :, 0] - lam * pr[:, :, 1]
        return jnp.einsum('bhqk,bkhe->bqhe', w, vf)

    return sweep_query_blocks(block, B, S)


def forgetting_attention(q, k, v, cum_log_f):
    B, S, H, Dh = q.shape
    qf = q.astype(jnp.float32) * (Dh ** -0.5)
    kf = k.astype(jnp.float32)
    vf = v.astype(jnp.float32)
    c_t = jnp.transpose(cum_log_f, (0, 2, 1))
    kpos = jnp.arange(S)

    def block(i):
        qb = lax.dynamic_slice_in_dim(qf, i * Q_BLOCK, Q_BLOCK, axis=1)
        cq = lax.dynamic_slice_in_dim(c_t, i * Q_BLOCK, Q_BLOCK, axis=2)
        qpos = i * Q_BLOCK + jnp.arange(Q_BLOCK)
        s = jnp.einsum('bqhd,bkhd->bhqk', qb, kf)
        s = s + (cq[..., :, None] - c_t[:, :, None, :])
        causal = kpos[None, :] <= qpos[:, None]
        s = jnp.where(causal[None, None], s, -jnp.inf)
        pr = jax.nn.softmax(s, axis=-1)
        return jnp.einsum('bhqk,bkhd->bqhd', pr, vf)

    return sweep_query_blocks(block, B, S)


def attention_mixer(hn, w_in, b_forget, w_out, lq1, lk1, lq2, lk2, subln, layer):
    B, S, _ = hn.shape
    z = hn @ w_in
    idx = [int(v) for v in np.cumsum(ATTN_IN_SPLIT)[:-1]]
    dq, dk, dv, fq, fk, fv, fz = jnp.split(z, idx, axis=-1)
    lam_init = 0.8 - 0.6 * math.exp(-0.3 * layer)
    lam = (jnp.exp(jnp.sum(lq1.astype(jnp.float32) * lk1.astype(jnp.float32)))
           - jnp.exp(jnp.sum(lq2.astype(jnp.float32) * lk2.astype(jnp.float32)))
           + lam_init)
    d_out = differential_attention(dq.reshape(B, S, DIFF_HEADS, 2, HEAD_DIM),
                                   dk.reshape(B, S, DIFF_HEADS, 2, HEAD_DIM),
                                   dv.reshape(B, S, DIFF_HEADS, 2 * HEAD_DIM), lam)
    d_out = rmsnorm(d_out, subln, eps=SUBLN_EPS) * (1.0 - lam_init)
    log_f = jax.nn.log_sigmoid(fz.astype(jnp.float32) + b_forget.astype(jnp.float32))
    cum_log_f = jnp.cumsum(log_f, axis=1)
    f_out = forgetting_attention(fq.reshape(B, S, FOX_HEADS, HEAD_DIM),
                                 fk.reshape(B, S, FOX_HEADS, HEAD_DIM),
                                 fv.reshape(B, S, FOX_HEADS, HEAD_DIM), cum_log_f)
    o = jnp.concatenate([d_out.reshape(B, S, DIFF_V), f_out.reshape(B, S, FOX_V)], axis=-1)
    return o.astype(hn.dtype) @ w_out


def _linear_recurrence_combine(earlier, later):
    a1, b1 = earlier
    a2, b2 = later
    return a1 * a2, a2 * b1 + b2


def recurrent_mixer(hn, w_in, conv_w, conv_b, wx, bx, wa, ba, a_param, w_out):
    B, S, _ = hn.shape
    gate_branch, xr = jnp.split(hn @ w_in, 2, axis=-1)
    y = jax.nn.gelu(gate_branch)
    xc = lax.conv_general_dilated(
        xr, conv_w.reshape(CONV_WIDTH, 1, RNN_WIDTH).astype(xr.dtype),
        window_strides=(1,), padding=[(CONV_WIDTH - 1, 0)],
        dimension_numbers=('NWC', 'WIO', 'NWC'),
        feature_group_count=RNN_WIDTH) + conv_b
    xb = xc.reshape(B, S, RNN_BLOCKS, RNN_BLOCK_W)
    gate_x = jax.nn.sigmoid(jnp.einsum('bsni,nij->bsnj', xb, wx).reshape(B, S, RNN_WIDTH) + bx)
    gate_a = jax.nn.sigmoid(jnp.einsum('bsni,nij->bsnj', xb, wa).reshape(B, S, RNN_WIDTH) + ba)
    log_a = RG_C * gate_a.astype(jnp.float32) * jax.nn.log_sigmoid(a_param.astype(jnp.float32))
    a = jnp.exp(log_a)
    mult = jnp.sqrt(-jnp.expm1(2.0 * log_a))
    mult = jnp.where((jnp.arange(S) == 0)[None, :, None], 1.0, mult)
    b = mult * gate_x.astype(jnp.float32) * xc.astype(jnp.float32)
    _, h = lax.associative_scan(_linear_recurrence_combine, (a, b), axis=1)
    return (h.astype(hn.dtype) * y) @ w_out


def setup_inputs(seed: int = 0) -> dict:
    key = jax.random.key(seed)
    ks = iter(jax.random.split(key, 40))

    def nrm(shape, scale):
        return jax.random.normal(next(ks), shape, jnp.float32) * scale

    def gain(shape):
        return 1.0 + nrm(shape, 0.02)

    NA, NR = N_ATTN_LAYERS, N_REC_LAYERS
    u = jax.random.uniform(next(ks), (NR, RNN_WIDTH), jnp.float32, 0.9, 0.999)
    s = u ** (1.0 / RG_C)
    a_param = jnp.log(s) - jnp.log1p(-s)
    return {
        "x": nrm((BATCH, SEQ, D_MODEL), 1.0),
        "p": nrm((DEPTH, BATCH, SEQ, PLE_DIM), 1.0),
        "ln_mix_pre": gain((DEPTH, D_MODEL)),
        "ln_mix_post": gain((DEPTH, D_MODEL)),
        "ln_mlp_pre": gain((DEPTH, D_MODEL)),
        "ln_mlp_post": gain((DEPTH, D_MODEL)),
        "mlp_w_up": nrm((DEPTH, D_MODEL, D_FF), D_MODEL ** -0.5),
        "mlp_w_down": nrm((DEPTH, D_FF, D_MODEL), D_FF ** -0.5),
        "ple_w_proj": nrm((DEPTH, PLE_DIM, D_MODEL), PLE_DIM ** -0.5),
        "ple_norm": gain((DEPTH, D_MODEL)),
        "ple_w_gate": nrm((DEPTH, D_MODEL, D_MODEL), D_MODEL ** -0.5),
        "attn_w_in": nrm((NA, D_MODEL, ATTN_IN_WIDTH), D_MODEL ** -0.5),
        "attn_b_forget": FORGET_BIAS_INIT + nrm((NA, FOX_HEADS), 0.1),
        "attn_w_out": nrm((NA, ATTN_OUT_WIDTH, D_MODEL), ATTN_OUT_WIDTH ** -0.5),
        "diff_lambda_q1": nrm((NA, HEAD_DIM), 0.1),
        "diff_lambda_k1": nrm((NA, HEAD_DIM), 0.1),
        "diff_lambda_q2": nrm((NA, HEAD_DIM), 0.1),
        "diff_lambda_k2": nrm((NA, HEAD_DIM), 0.1),
        "diff_subln": gain((NA, 2 * HEAD_DIM)),
        "rec_w_in": nrm((NR, D_MODEL, 2 * RNN_WIDTH), D_MODEL ** -0.5),
        "rec_conv_w": nrm((NR, CONV_WIDTH, RNN_WIDTH), CONV_WIDTH ** -0.5),
        "rec_conv_b": nrm((NR, RNN_WIDTH), 0.01),
        "rec_wx": nrm((NR, RNN_BLOCKS, RNN_BLOCK_W, RNN_BLOCK_W), RNN_BLOCK_W ** -0.5),
        "rec_bx": nrm((NR, RNN_WIDTH), 0.01),
        "rec_wa": nrm((NR, RNN_BLOCKS, RNN_BLOCK_W, RNN_BLOCK_W), RNN_BLOCK_W ** -0.5),
        "rec_ba": nrm((NR, RNN_WIDTH), 0.01),
        "rec_a_param": a_param,
        "rec_w_out": nrm((NR, RNN_WIDTH, D_MODEL), RNN_WIDTH ** -0.5),
    }


def reference(x, p, ln_mix_pre, ln_mix_post, ln_mlp_pre, ln_mlp_post, mlp_w_up, mlp_w_down,
              ple_w_proj, ple_norm, ple_w_gate, attn_w_in, attn_b_forget, attn_w_out,
              diff_lambda_q1, diff_lambda_k1, diff_lambda_q2, diff_lambda_k2, diff_subln,
              rec_w_in, rec_conv_w, rec_conv_b, rec_wx, rec_bx, rec_wa, rec_ba,
              rec_a_param, rec_w_out):
    h = x
    for layer in range(DEPTH):
        j = layer // 2
        hn = rmsnorm(h, ln_mix_pre[layer])
        if layer % 2 == 0:
            m = attention_mixer(hn, attn_w_in[j], attn_b_forget[j], attn_w_out[j],
                                diff_lambda_q1[j], diff_lambda_k1[j],
                                diff_lambda_q2[j], diff_lambda_k2[j], diff_subln[j], layer)
        else:
            m = recurrent_mixer(hn, rec_w_in[j], rec_conv_w[j], rec_conv_b[j], rec_wx[j],
                                rec_bx[j], rec_wa[j], rec_ba[j], rec_a_param[j], rec_w_out[j])
        h = h + rmsnorm(m, ln_mix_post[layer])
        u = rmsnorm(h, ln_mlp_pre[layer])
        f = jnp.square(jax.nn.relu(u @ mlp_w_up[layer])) @ mlp_w_down[layer]
        h = h + rmsnorm(f, ln_mlp_post[layer])
        e = rmsnorm(p[layer] @ ple_w_proj[layer], ple_norm[layer])
        h = h + e * jax.nn.sigmoid(h @ ple_w_gate[layer])
    return h
```

```cpp
#include <hip/hip_runtime.h>
#include <hip/hip_cooperative_groups.h>
#include <cstdio>
#include <cstdint>
namespace pg8 {
#define PG8_LAS __attribute__((address_space(3)))
typedef unsigned short bf16_t;
typedef short bf16x8 __attribute__((ext_vector_type(8)));
typedef float f32x4 __attribute__((ext_vector_type(4)));
typedef unsigned u32x4 __attribute__((ext_vector_type(4)));
constexpr int BM = 256, BK = 64, HALF = 128, HTB = HALF * BK * 2  , STAGE_BYTES = 8 * HTB, NXCD = 8, WGM = 8;

__host__ __device__ __forceinline__ int lds_byte(int r, int c) { const int st = (r >> 4) * 2 + (c >> 5), rr = r & 15, cc = c & 31, ob = rr * 64 + cc * 2; return st * 1024 + (ob ^ (((ob >> 9) & 1) << 5)); }
__host__ __device__ __forceinline__ void stage_rc(int b, int& R, int& C) { const int st = b / 1024, sb = b % 1024, swz = sb ^ (((sb >> 9) & 1) << 5); R = (st >> 1) * 16 + swz / 64; C = (st & 1) * 32 + (swz % 64) / 2; }
__host__ __device__ __forceinline__ int perm32(int rho) { const int n = rho >> 4, i = rho & 15; return 8 * (i >> 2) + 4 * n + (i & 3); }

__device__ __forceinline__ int otid() { int t = threadIdx.x; asm volatile("" : "+v"(t)); return t; }
struct Unit { int pm, pn; };
struct Gemm { const bf16_t* A; const bf16_t* Bt; int M, N, K; };

struct StaticOrder {
    int nM, nN, nwg, G, c;
    __host__ __device__ void init(int M, int N, int G_, int c_) { nM = M / BM; nN = N / BM; nwg = nM * nN; G = G_; c = c_; }
    __host__ __device__ bool next(int i, Unit& u) const {
        const long L = (long)i * G + c; if (L >= nwg) return false;
        int wgid = (int)L; { const int q = nwg / NXCD, r = nwg % NXCD, xcd = wgid % NXCD, off = wgid / NXCD; wgid = (xcd < r ? xcd * (q + 1) : r * (q + 1) + (xcd - r) * q) + off; }
        const int nig = WGM * nN, gid = wgid / nig, fm = gid * WGM, gsz = (nM - fm) < WGM ? (nM - fm) : WGM;
        u.pm = fm + ((wgid % nig) % gsz); u.pn = (wgid % nig) / gsz; return true;
    }
    __device__ __forceinline__ void a_ready(const Unit&) const {}
    __device__ __forceinline__ void done(const Unit&) const {}
};

__device__ __forceinline__ unsigned cvt_pk_bf16(float lo, float hi) { unsigned r; asm volatile("v_cvt_pk_bf16_f32 %0, %1, %2" : "=v"(r) : "v"(lo), "v"(hi)); return r; }
typedef float f32x2 __attribute__((ext_vector_type(2)));
__device__ __forceinline__ float bf_lo(unsigned w) { return __uint_as_float(w << 16); }
__device__ __forceinline__ float bf_hi(unsigned w) { return __uint_as_float(w & 0xffff0000u); }
__device__ __forceinline__ float sigmoid_f(float v) { return __builtin_amdgcn_rcpf(1.0f + __builtin_amdgcn_exp2f(-1.4426950408889634f * v)); }
__device__ __forceinline__ float gelu_tanh_f(float v) { const float z = 1.5957691216057308f * (v + 0.044715f * v * v * v); return v * sigmoid_f(z); }
template <int MODE> struct EpiX {
    static constexpr bool PERM = true, AFTER_DRAIN = false;
    bf16_t* O; int ldc; float scale0; unsigned scale_mask; bf16_t* O2; float* H; const bf16_t* E;
    __device__ __forceinline__ void operator()(const f32x4 (&acc)[2][2][4][2], const Unit& u, int wr, int wc, int fr, int fq) const {
        const int row0 = u.pm * BM + wr * 64 + fr; const int col0 = u.pn * BM + wc * 32 + 8 * fq;
        float sc = 1.f; if (MODE == 0) sc = ((scale_mask >> u.pn) & 1u) ? scale0 : 1.f;
#pragma unroll
        for (int ai = 0; ai < 2; ++ai)
#pragma unroll
            for (int m = 0; m < 4; ++m) { const size_t row = (size_t)(row0 + ai * HALF + m * 16);
#pragma unroll
                for (int bj = 0; bj < 2; ++bj) { f32x4 v0 = acc[ai][bj][m][0], v1 = acc[ai][bj][m][1]; const int col = col0 + bj * HALF;
                    if (MODE == 3) {
                        float* hp = H + row * ldc + col; const u32x4 ev = *(const u32x4*)(E + row * ldc + col);
                        f32x4 h0 = *(const f32x4*)hp, h1 = *(const f32x4*)(hp + 4);
                        h0[0] += bf_lo(ev.x) * sigmoid_f(v0[0]); h0[1] += bf_hi(ev.x) * sigmoid_f(v0[1]); h0[2] += bf_lo(ev.y) * sigmoid_f(v0[2]); h0[3] += bf_hi(ev.y) * sigmoid_f(v0[3]);
                        h1[0] += bf_lo(ev.z) * sigmoid_f(v1[0]); h1[1] += bf_hi(ev.z) * sigmoid_f(v1[1]); h1[2] += bf_lo(ev.w) * sigmoid_f(v1[2]); h1[3] += bf_hi(ev.w) * sigmoid_f(v1[3]);
                        *(f32x4*)hp = h0; *(f32x4*)(hp + 4) = h1;
                    } else {
                        bf16_t* dst = O + row * ldc + col;
                        if (MODE == 0) { v0 = v0 * sc; v1 = v1 * sc; }
                        if (MODE == 1) {
#pragma unroll
                            for (int e = 0; e < 4; ++e) { const float a = __builtin_fmaxf(v0[e], 0.f), b = __builtin_fmaxf(v1[e], 0.f); v0[e] = a * a; v1[e] = b * b; } }
                        if (MODE == 2) { if (u.pn < 5) {
#pragma unroll
                            for (int e = 0; e < 4; ++e) { v0[e] = gelu_tanh_f(v0[e]); v1[e] = gelu_tanh_f(v1[e]); } } else dst = O2 + row * ldc + (col - 1280); }
                        u32x4 w; w.x = cvt_pk_bf16(v0[0], v0[1]); w.y = cvt_pk_bf16(v0[2], v0[3]); w.z = cvt_pk_bf16(v1[0], v1[1]); w.w = cvt_pk_bf16(v1[2], v1[3]);
                        *(u32x4*)dst = w;
                    } } }
    }
};

template <class Epi, class Sched, bool ALIGN_EPI = false, bool SP2 = false>
__device__ __forceinline__ void gemm_phase(PG8_LAS unsigned char* lds, const Gemm g, const Sched& S, const Epi& E) {
    const int tid = otid(), wid = __builtin_amdgcn_readfirstlane(tid >> 6), lane = tid & 63, wr = wid >> 2, wc = wid & 3, fr = lane & 15, fq = lane >> 4;
    const int K = g.K, nt = K / BK;
    unsigned voffA[2], voffB[2];
#pragma unroll
    for (int i = 0; i < 2; ++i) { int R, C; stage_rc(tid * 16 + i * 8192, R, C); const int Rb = Epi::PERM ? ((R & ~31) + perm32(R & 31)) : R;
        voffA[i] = (unsigned)(R * K + C) * 2u; voffB[i] = (unsigned)(Rb * K + C) * 2u; }
    const size_t kstep = (size_t)(BK * 2);
    const size_t hstep = (size_t)HALF * K * 2;
    const size_t tstep = 2 * hstep;
    const unsigned ldsw = (unsigned)wid * 1024u;
    const int aoff = lds_byte(wr * 64 + fr, fq * 8), boff = lds_byte(wc * 32 + fr, fq * 8);
#define PG8_SA(b, h) (((b) * 2 + (h)) * HTB)
#define PG8_SB(b, h) ((4 + (b) * 2 + (h)) * HTB)
#define PG8_STAGE(bufoff, gbase, voff) do { _Pragma("unroll") for (int _i = 0; _i < 2; ++_i) \
        __builtin_amdgcn_global_load_lds((const unsigned*)((const char*)(gbase) + (voff)[_i]), (PG8_LAS unsigned*)(lds + (bufoff) + ldsw + _i * 8192), 16, 0, 0); } while (0)
#define PG8_LDA(dst, b, h) do { _Pragma("unroll") for (int m = 0; m < 4; ++m) _Pragma("unroll") for (int k = 0; k < 2; ++k) dst[m][k] = *(const PG8_LAS bf16x8*)(lds + PG8_SA(b, h) + aoff + m * 2048 + k * 1024); } while (0)
#define PG8_LDB(dst, b, h) do { _Pragma("unroll") for (int n = 0; n < 2; ++n) _Pragma("unroll") for (int k = 0; k < 2; ++k) dst[n][k] = *(const PG8_LAS bf16x8*)(lds + PG8_SB(b, h) + boff + n * 2048 + k * 1024); } while (0)
#define PG8_MMA(ai, bj, At, Bt) do { __builtin_amdgcn_s_setprio(1); _Pragma("unroll") for (int m = 0; m < 4; ++m) _Pragma("unroll") for (int n = 0; n < 2; ++n) _Pragma("unroll") for (int k = 0; k < 2; ++k) \
        acc[ai][bj][m][n] = __builtin_amdgcn_mfma_f32_16x16x32_bf16(Bt[n][k], At[m][k], acc[ai][bj][m][n], 0, 0, 0); __builtin_amdgcn_s_setprio(0); } while (0)
#define PG8_WAIT_V(n) asm volatile("s_waitcnt vmcnt(" #n ")" ::: "memory")
#define PG8_WAIT_L(n) asm volatile("s_waitcnt lgkmcnt(" #n ")" ::: "memory")
#define PG8_BAR __builtin_amdgcn_s_barrier()
#define PG8_SCHED __builtin_amdgcn_sched_barrier(0)
    Unit cur, nxt; int ui = 0;
    if (!S.next(0, cur)) return;
    f32x4 acc[2][2][4][2];
#pragma unroll
    for (int a = 0; a < 2; ++a)
#pragma unroll
        for (int b = 0; b < 2; ++b)
#pragma unroll
            for (int m = 0; m < 4; ++m)
#pragma unroll
                for (int n = 0; n < 2; ++n) acc[a][b][m][n] = (f32x4){0.f, 0.f, 0.f, 0.f};
    bf16x8 At[4][2], B0[2][2], B1[2][2];
    const char* cA = (const char*)g.A + (size_t)cur.pm * tstep; const char* cB = (const char*)g.Bt + (size_t)cur.pn * tstep;
    S.a_ready(cur);
    if constexpr (SP2) {
        PG8_STAGE(PG8_SB(0, 0), cB, voffB); PG8_STAGE(PG8_SB(0, 1), cB + hstep, voffB); PG8_STAGE(PG8_SA(0, 0), cA, voffA); PG8_STAGE(PG8_SA(0, 1), cA + hstep, voffA);
        if (wr == 1) PG8_BAR;
        PG8_WAIT_V(2); PG8_BAR;
        PG8_STAGE(PG8_SB(1, 0), cB + kstep, voffB); PG8_STAGE(PG8_SA(1, 0), cA + kstep, voffA); PG8_STAGE(PG8_SB(1, 1), cB + hstep + kstep, voffB);
        PG8_WAIT_V(6); PG8_BAR;
    } else {
        PG8_STAGE(PG8_SB(0, 0), cB, voffB); PG8_STAGE(PG8_SA(0, 0), cA, voffA); PG8_STAGE(PG8_SB(0, 1), cB + hstep, voffB); PG8_STAGE(PG8_SA(0, 1), cA + hstep, voffA);
        if (wr == 1) PG8_BAR;
        PG8_WAIT_V(4); PG8_BAR;
        PG8_STAGE(PG8_SB(1, 0), cB + kstep, voffB); PG8_STAGE(PG8_SA(1, 0), cA + kstep, voffA); PG8_STAGE(PG8_SB(1, 1), cB + hstep + kstep, voffB);
        PG8_WAIT_V(6); PG8_BAR;
    }
    for (;;) {
        const bool has_next = S.next(ui + 1, nxt);
        const char* nA = has_next ? (const char*)g.A + (size_t)nxt.pm * tstep : cA; const char* nB = has_next ? (const char*)g.Bt + (size_t)nxt.pn * tstep : cB;
        for (int t = 0; t < nt; t += 2) {
            const bool last = (t == nt - 2);
            const char* a1 = cA + (size_t)(t + 1) * kstep;
            const char* a2 = last ? nA : cA + (size_t)(t + 2) * kstep; const char* b2 = last ? nB : cB + (size_t)(t + 2) * kstep;
            const char* a3 = a2 + kstep; const char* b3 = b2 + kstep;
            if (last && has_next) S.a_ready(nxt);
            if constexpr (SP2) {
            PG8_LDB(B0, 0, 0); PG8_LDB(B1, 0, 1); PG8_SCHED; PG8_LDA(At, 0, 0); PG8_STAGE(PG8_SA(1, 1), a1 + hstep, voffA);
            PG8_WAIT_V(8); PG8_WAIT_L(0); PG8_BAR; PG8_MMA(0, 0, At, B0); PG8_MMA(0, 1, At, B1); PG8_BAR; PG8_SCHED;
            PG8_LDA(At, 0, 1); PG8_STAGE(PG8_SB(0, 0), b2, voffB); PG8_STAGE(PG8_SB(0, 1), b2 + hstep, voffB); PG8_STAGE(PG8_SA(0, 0), a2, voffA);
            PG8_WAIT_V(8); PG8_WAIT_L(0); PG8_BAR; PG8_MMA(1, 0, At, B0); PG8_MMA(1, 1, At, B1); PG8_BAR; PG8_SCHED;
            PG8_LDB(B0, 1, 0); PG8_LDB(B1, 1, 1); PG8_SCHED; PG8_LDA(At, 1, 0); PG8_STAGE(PG8_SA(0, 1), a2 + hstep, voffA);
            PG8_WAIT_V(8); PG8_WAIT_L(0); PG8_BAR; PG8_MMA(0, 0, At, B0); PG8_MMA(0, 1, At, B1); PG8_BAR; PG8_SCHED;
            PG8_LDA(At, 1, 1); PG8_STAGE(PG8_SB(1, 0), b3, voffB); PG8_STAGE(PG8_SB(1, 1), b3 + hstep, voffB); PG8_STAGE(PG8_SA(1, 0), a3, voffA);
            PG8_WAIT_V(8); PG8_WAIT_L(0); PG8_BAR; PG8_MMA(1, 0, At, B0); PG8_MMA(1, 1, At, B1); PG8_BAR; PG8_SCHED;
            } else {
            PG8_LDB(B0, 0, 0); PG8_SCHED; PG8_LDA(At, 0, 0); PG8_STAGE(PG8_SA(1, 1), a1 + hstep, voffA);
            PG8_WAIT_L(8); PG8_BAR; PG8_WAIT_L(0); PG8_MMA(0, 0, At, B0); PG8_BAR; PG8_SCHED;
            PG8_LDB(B1, 0, 1); PG8_STAGE(PG8_SB(0, 0), b2, voffB);
            PG8_BAR; PG8_WAIT_L(0); PG8_MMA(0, 1, At, B1); PG8_BAR;
            PG8_LDA(At, 0, 1); PG8_STAGE(PG8_SA(0, 0), a2, voffA);
            PG8_BAR; PG8_WAIT_L(0); PG8_MMA(1, 0, At, B0); PG8_BAR; PG8_SCHED;
            PG8_STAGE(PG8_SB(0, 1), b2 + hstep, voffB);
            PG8_WAIT_V(6); PG8_BAR; PG8_MMA(1, 1, At, B1); PG8_BAR;
            PG8_LDB(B0, 1, 0); PG8_SCHED; PG8_LDA(At, 1, 0); PG8_STAGE(PG8_SA(0, 1), a2 + hstep, voffA);
            PG8_WAIT_L(8); PG8_BAR; PG8_WAIT_L(0); PG8_MMA(0, 0, At, B0); PG8_BAR; PG8_SCHED;
            PG8_LDB(B1, 1, 1); PG8_STAGE(PG8_SB(1, 0), b3, voffB);
            PG8_BAR; PG8_WAIT_L(0); PG8_MMA(0, 1, At, B1); PG8_BAR;
            PG8_LDA(At, 1, 1); PG8_STAGE(PG8_SA(1, 0), a3, voffA);
            PG8_BAR; PG8_WAIT_L(0); PG8_MMA(1, 0, At, B0); PG8_BAR; PG8_SCHED;
            PG8_STAGE(PG8_SB(1, 1), b3 + hstep, voffB);
            PG8_WAIT_V(6); PG8_BAR; PG8_MMA(1, 1, At, B1); PG8_BAR;
            }
        }
        if constexpr (ALIGN_EPI) { if (wr == 0) PG8_BAR; }
        if constexpr (!Epi::AFTER_DRAIN) { E(acc, cur, wr, wc, fr, fq); S.done(cur); }
        if (!has_next) break;
#pragma unroll
        for (int a = 0; a < 2; ++a)
#pragma unroll
            for (int b = 0; b < 2; ++b)
#pragma unroll
                for (int m = 0; m < 4; ++m)
#pragma unroll
                    for (int n = 0; n < 2; ++n) acc[a][b][m][n] = (f32x4){0.f, 0.f, 0.f, 0.f};
        cur = nxt; cA = nA; cB = nB; ++ui;
        if constexpr (ALIGN_EPI) { if (wr == 1) PG8_BAR; }
    }
    PG8_WAIT_V(0);
    if constexpr (!ALIGN_EPI) { if (wr == 0) PG8_BAR; }
    PG8_BAR;
    if constexpr (Epi::AFTER_DRAIN) { E.fused(acc, cur, wr, wc, fr, fq, lds, wid, lane); S.done(cur); }
#undef PG8_SA
#undef PG8_SB
#undef PG8_STAGE
#undef PG8_LDA
#undef PG8_LDB
#undef PG8_MMA
#undef PG8_WAIT_V
#undef PG8_WAIT_L
#undef PG8_BAR
#undef PG8_SCHED
}
}
#include <hip/hip_bf16.h>
#include <cmath>
namespace attn_body {
using bf16=__hip_bfloat16;
using bf16x8=__attribute__((ext_vector_type(8)))short;
using s16x4=__attribute__((ext_vector_type(4)))short;
using f32x16=__attribute__((ext_vector_type(16)))float;
using u32x4=__attribute__((ext_vector_type(4)))unsigned;
constexpr int SEQ=4096,D=64,DM=3072;
constexpr int NW=8,QBLK=32,QB=QBLK*NW,KVBLK=64,NQB=SEQ/QB;
constexpr int ATTN_PITCH=DM, ATTN_UNIT_ROWS=QB;
__device__ __forceinline__ int crow(int r,int hi){return (r&3)+8*(r>>2)+4*hi;}
#define SBAR() __builtin_amdgcn_sched_barrier(0)
__device__ __forceinline__ void cmask(f32x16&p0,f32x16&p1,int jb,int qrel,int hi){
  const float NEG=-INFINITY; int kb=64*jb+4*hi;
  #pragma unroll
  for(int r=0;r<16;++r){int kv=kb+(r&3)+8*(r>>2); if(kv>qrel)p0[r]=NEG; if(kv+32>qrel)p1[r]=NEG;}
}

constexpr int NSLOT=3, SLOTB=8192;
constexpr int LDS_K=0, LDS_V=NSLOT*SLOTB, LDS_WS=2*NSLOT*SLOTB, LDS_OST=LDS_WS+NW*64*4, LDS_BIAS=LDS_OST+NW*4096, LDS_BYTES=LDS_BIAS+SEQ*4;
constexpr float C2=0.125f*1.4426950408889634f;
__device__ __forceinline__ void glds16(const void*gsrc,unsigned lds_dst){unsigned keep;
  asm volatile("s_mov_b32 %0, m0\n\ts_mov_b32 m0, %2\n\ts_nop 0\n\tglobal_load_lds_dwordx4 %1, off\n\ts_mov_b32 m0, %0":"=&s"(keep):"v"(gsrc),"s"(lds_dst):"memory");}
__device__ __forceinline__ float max3f(float a,float b,float c){float r;asm("v_max3_f32 %0, %1, %2, %3":"=v"(r):"v"(a),"v"(b),"v"(c));return r;}
__device__ __forceinline__ float max2f(float a,float b){float r;asm("v_max_f32_e32 %0, %1, %2":"=v"(r):"v"(a),"v"(b));return r;}
__device__ __forceinline__ float fadd_s(float a,float b){float r;asm("v_add_f32_e32 %0, %1, %2":"=v"(r):"v"(a),"v"(b));return r;}
__device__ __forceinline__ float fsub_s(float a,float b){float r;asm("v_sub_f32_e32 %0, %1, %2":"=v"(r):"v"(a),"v"(b));return r;}
typedef float f32x2_t __attribute__((ext_vector_type(2))); typedef __bf16 bf16x2_t __attribute__((ext_vector_type(2)));
__device__ __forceinline__ unsigned cvtpk_s(float lo,float hi){f32x2_t v={lo,hi};bf16x2_t b=__builtin_convertvector(v,bf16x2_t);return __builtin_bit_cast(unsigned,b);}
#define WAIT_BAR(N) asm volatile("s_waitcnt vmcnt(" #N ") lgkmcnt(0)\n\ts_barrier":::"memory")

__device__ __forceinline__ bf16x8 bias_frag(float v,int hi){
  const unsigned h1=cvtpk_s(v,0.f)&0xffffu; const float r1=v-__uint_as_float(h1<<16);
  const unsigned h2=cvtpk_s(r1,0.f)&0xffffu; const float r2=r1-__uint_as_float(h2<<16);
  const unsigned h3=cvtpk_s(r2,0.f)&0xffffu;
  u32x4 w; w.x=hi?0u:(h1|(h2<<16)); w.y=hi?0u:(h3|0x3f800000u); w.z=hi?0u:0x3f803f80u; w.w=0u; return __builtin_bit_cast(bf16x8,w);
}
__device__ __forceinline__ bf16x8 ref_frag(float v){
  const unsigned h1=cvtpk_s(v,0.f)&0xffffu; const float r1=v-__uint_as_float(h1<<16);
  const unsigned h2=cvtpk_s(r1,0.f)&0xffffu; const float r2=r1-__uint_as_float(h2<<16);
  const unsigned h3=cvtpk_s(r2,0.f)&0xffffu;
  u32x4 w; w.x=0x3f803f80u; w.y=0x3f80u|(h1<<16); w.z=h2|(h3<<16); w.w=0u; return __builtin_bit_cast(bf16x8,w);
}
__device__ __forceinline__ void qkt(f32x16&p0,f32x16&p1,const char*Kslot,const bf16x8*qr,bf16x8 qx,int r32,int hi,float bv0,float bv1){
  const char*kb=Kslot+hi*1024+r32*16;
  p0=__builtin_amdgcn_mfma_f32_32x32x16_bf16(bias_frag(bv0,hi),qx,f32x16{},0,0,0);
  p1=__builtin_amdgcn_mfma_f32_32x32x16_bf16(bias_frag(bv1,hi),qx,f32x16{},0,0,0);
  #pragma unroll
  for(int d0=0;d0<4;++d0){
    const bf16x8 b0=*reinterpret_cast<const bf16x8*>(kb+d0*2048);
    const bf16x8 b1=*reinterpret_cast<const bf16x8*>(kb+d0*2048+512);
    p0=__builtin_amdgcn_mfma_f32_32x32x16_bf16(b0,qr[d0],p0,0,0,0);p1=__builtin_amdgcn_mfma_f32_32x32x16_bf16(b1,qr[d0],p1,0,0,0);}
}
typedef __attribute__((address_space(3))) const char* lds_cptr;
typedef short v4i16_t __attribute__((ext_vector_type(4)));
__device__ __forceinline__ void kload8(bf16x8*kf,lds_cptr kp){
  kf[0]=*(const __attribute__((address_space(3))) bf16x8*)(kp);      kf[1]=*(const __attribute__((address_space(3))) bf16x8*)(kp+512);
  kf[2]=*(const __attribute__((address_space(3))) bf16x8*)(kp+2048); kf[3]=*(const __attribute__((address_space(3))) bf16x8*)(kp+2560);
  kf[4]=*(const __attribute__((address_space(3))) bf16x8*)(kp+4096); kf[5]=*(const __attribute__((address_space(3))) bf16x8*)(kp+4608);
  kf[6]=*(const __attribute__((address_space(3))) bf16x8*)(kp+6144); kf[7]=*(const __attribute__((address_space(3))) bf16x8*)(kp+6656);
}
__device__ __forceinline__ void kload2(bf16x8*kf,lds_cptr kp,int j){ kf[2*j]=*(const __attribute__((address_space(3))) bf16x8*)(kp+j*2048); kf[2*j+1]=*(const __attribute__((address_space(3))) bf16x8*)(kp+j*2048+512); }
__device__ __forceinline__ s16x4 vtr(lds_cptr p){ return __builtin_bit_cast(s16x4,__builtin_amdgcn_ds_read_tr16_b64_v4i16((__attribute__((address_space(3))) v4i16_t*)p)); }
__device__ __forceinline__ float rowmax(const f32x16&p0,const f32x16&p1){
  float a=max3f(p0[0],p0[1],p1[0]),b=max3f(p0[2],p0[3],p1[1]);a=max3f(a,p1[2],p1[3]);
  #pragma unroll
  for(int r=4;r<16;r+=4){a=max3f(a,p0[r],p0[r+1]);b=max3f(b,p0[r+2],p0[r+3]);a=max3f(a,p1[r],p1[r+1]);b=max3f(b,p1[r+2],p1[r+3]);}
  const float m=max2f(a,b);
  auto rr=__builtin_amdgcn_permlane32_swap(__float_as_uint(m),__float_as_uint(m),false,false);
  return max2f(__uint_as_float(rr[0]),__uint_as_float(rr[1]));
}
__device__ __forceinline__ void pv(f32x16*o,int vb,bf16x8 pa0,bf16x8 pa1,bf16x8 pa2,bf16x8 pa3){
  #pragma unroll
  for(int d0=0;d0<2;++d0){s16x4 lo[4],hi[4];
    #pragma unroll
    for(int ks=0;ks<4;++ks){
      asm volatile("ds_read_b64_tr_b16 %0,%1 offset:%c2":"=&v"(lo[ks]):"v"(vb),"i"(d0*4096+ks*1024):"memory");
      asm volatile("ds_read_b64_tr_b16 %0,%1 offset:%c2":"=&v"(hi[ks]):"v"(vb),"i"(d0*4096+ks*1024+512):"memory");}
    asm volatile("s_waitcnt lgkmcnt(0)":::"memory");SBAR();
    #define PK(k) (bf16x8){lo[k][0],lo[k][1],lo[k][2],lo[k][3],hi[k][0],hi[k][1],hi[k][2],hi[k][3]}
    o[d0]=__builtin_amdgcn_mfma_f32_32x32x16_bf16(pa0,PK(0),o[d0],0,0,0);
    o[d0]=__builtin_amdgcn_mfma_f32_32x32x16_bf16(pa1,PK(1),o[d0],0,0,0);
    o[d0]=__builtin_amdgcn_mfma_f32_32x32x16_bf16(pa2,PK(2),o[d0],0,0,0);
    o[d0]=__builtin_amdgcn_mfma_f32_32x32x16_bf16(pa3,PK(3),o[d0],0,0,0);
    #undef PK
  }
}

#ifndef ATTN_STORE16
#define ATTN_STORE16(p,v) (*(u32x4*)(p)=(v))
#endif
template<int THRL> __device__ __forceinline__ void attn_unit(long rowbase,int qb,const bf16*Qh,const bf16*__restrict__ Kh0,const bf16*__restrict__ Vh0,bf16*Oh,int OP,const float*__restrict__ btab,float slope2,char*shm){
  const int tid=pg8::otid(),lane=tid&63,r32=lane&31,hi=lane>>5; const int wid=__builtin_amdgcn_readfirstlane(tid>>6);
  const int q0=qb*QB;
  const bf16*Qw=Qh+(rowbase+q0+wid*QBLK)*DM;
  const bf16*Kh=Kh0+rowbase*DM,*Vh=Vh0+rowbase*DM;
  const unsigned lds0=(unsigned)(uintptr_t)shm;
  float*wsf=(float*)(shm+LDS_WS)+wid*64;
  const bf16*ksrc=Kh+(long)lane*DM+wid*8;
  const bf16*vsrc=Vh+(long)(16*(wid&3)+(lane>>2))*DM+(wid>>2)*32+(lane&3)*8;
  const unsigned kdst=lds0+LDS_K+wid*1024, vdst=lds0+LDS_V+wid*1024;
  #define DMA_K(t,slot) glds16(ksrc+(long)(t)*KVBLK*DM,(unsigned)__builtin_amdgcn_readfirstlane(kdst+(slot)))
  #define DMA_V(t,slot) glds16(vsrc+(long)(t)*KVBLK*DM,(unsigned)__builtin_amdgcn_readfirstlane(vdst+(slot)))
  const int vb0=(int)(lds0+LDS_V)+((lane>>4)&1)*32+(lane&3)*8+(4*hi+((lane&15)>>2))*64;
  const char*Kbase=shm+LDS_K; bf16x8 kf[8];
  const lds_cptr shm3=(lds_cptr)shm; const lds_cptr kp0=shm3+LDS_K+hi*1024+r32*16; const lds_cptr vp0=shm3+LDS_V+((lane>>4)&1)*32+(lane&3)*8+(4*hi+((lane&15)>>2))*64;
  const int NT=(q0+QB)/KVBLK;
  typedef __attribute__((address_space(3))) float lds_f32;
  { lds_f32*bw=(lds_f32*)(shm3+LDS_BIAS);
    for(int i=tid;i<NT*KVBLK;i+=NW*64) bw[i]=btab?btab[i]:slope2*(float)i; }
  const lds_f32*bl3=(const lds_f32*)(shm3+LDS_BIAS)+r32;
  DMA_K(0,0);DMA_V(0,0);DMA_K(1,SLOTB);
  bf16x8 qr[4];
  #pragma unroll
  for(int d0=0;d0<4;++d0)qr[d0]=*reinterpret_cast<const bf16x8*>(&Qw[(long)r32*DM+d0*16+hi*8]);
  float mhat=0.f,l_reg=0.f;f32x16 o[2];o[0]=f32x16{};o[1]=f32x16{};bf16x8 qx=ref_frag(0.f);
  const int qrel=wid*QBLK+r32;
  #define CMASK(P0,P1,t) do{int jb_=(t)-(NT-4); if(jb_>=0)cmask(P0,P1,jb_,qrel,hi);}while(0)
  bool resc=false;
  #define START(P0,P1) do{ const float rm=rowmax(P0,P1); resc=false; \
    { const float dl=rm; mhat=fadd_s(mhat,dl); \
      _Pragma("unroll") for(int r=0;r<16;++r){P0[r]=fsub_s(P0[r],dl);P1[r]=fsub_s(P1[r],dl);} \
      qx=ref_frag(-mhat); } \
    _Pragma("unroll") for(int r=0;r<16;++r)P0[r]=__builtin_amdgcn_exp2f(P0[r]); }while(0)
  #define RESC() do{ if(resc){ asm volatile("s_waitcnt lgkmcnt(0)":::"memory"); \
      _Pragma("unroll") for(int d_=0;d_<2;++d_) _Pragma("unroll") for(int r=0;r<16;++r)o[d_][r]*=wsf[crow(r,hi)]; } }while(0)
  f32x16 pA0,pA1,pB0,pB1;
  int sl_prev=0,sl_cur=0,sl_next=SLOTB;
  #define ROT() do{sl_prev=sl_cur;sl_cur=sl_next;sl_next=(sl_next==(NSLOT-1)*SLOTB)?0:sl_next+SLOTB;}while(0)
  DMA_K(2,2*SLOTB);
  WAIT_BAR(3);
  qkt(pA0,pA1,Kbase,qr,qx,r32,hi,bl3[0],bl3[32]);asm volatile("s_nop 15\n\ts_nop 7":"+v"(pA0),"+v"(pA1));CMASK(pA0,pA1,0);
  START(pA0,pA1);
  _Pragma("unroll") for(int r=0;r<16;++r)pA1[r]=__builtin_amdgcn_exp2f(pA1[r]);
  WAIT_BAR(0);
  DMA_K(3,0);DMA_V(1,SLOTB);
  ROT();
  kload8(kf,kp0+sl_cur);
  WAIT_BAR(2);
  s16x4 vlo[8],vhi[8]; u32x4 pw0,pw1,pw2,pw3;
  #define PKW(P,B) cvtpk_s(P[B],P[B+1])
  #define PAF(k) __builtin_bit_cast(bf16x8,pw##k)
  #define VFR(i) (bf16x8){vlo[i][0],vlo[i][1],vlo[i][2],vlo[i][3],vhi[i][0],vhi[i][1],vhi[i][2],vhi[i][3]}
  #define PIN(x) asm volatile("":"+v"(x))
  #define MX3(a,b,c) __builtin_fmaxf(__builtin_fmaxf((a),(b)),(c))
  #define GAPA(MF,A0,A1,A2,A3,W0,W1,PW) do{ MF; sacc+=A0; sacc+=A1; sacc+=A2; sacc+=A3; PIN(sacc); W0; W1; PIN(PW); SBAR(); }while(0)
  #define EX(v) __builtin_amdgcn_exp2f(v)
  #define GAPB(MF,X,B) do{ MF; X[B]=EX(X[B]); X[B+1]=EX(X[B+1]); X[B+2]=EX(X[B+2]); X[B+3]=EX(X[B+3]); PIN(X); SBAR(); }while(0)
  #define VRD(i) do{ vlo[i]=vtr(vp_+(((i)>>2)*4096+((i)&3)*1024)); vhi[i]=vtr(vp_+(((i)>>2)*4096+((i)&3)*1024+512)); }while(0)
  #define KRD(G,j) do{ if(G){ kload2(kf,kp0+sl_next,j); SBAR(); } }while(0)
  #define STEP(C0,C1,P0,P1,t,GK,GV,GL) do{ SBAR(); \
    const lds_cptr vp_=vp0+sl_prev; \
    { const float bv0_=bl3[(t)*KVBLK], bv1_=bl3[(t)*KVBLK+32]; \
      C0=__builtin_amdgcn_mfma_f32_32x32x16_bf16(bias_frag(bv0_,hi),qx,f32x16{},0,0,0); \
      C1=__builtin_amdgcn_mfma_f32_32x32x16_bf16(bias_frag(bv1_,hi),qx,f32x16{},0,0,0); } SBAR(); \
    VRD(0); SBAR(); float sacc=(P0[0]+P0[1]); \
    GAPA(C0=__builtin_amdgcn_mfma_f32_32x32x16_bf16(kf[0],qr[0],C0,0,0,0), P0[2],P0[3],P0[4],P0[5],     pw0[0]=PKW(P0,0), pw0[1]=PKW(P0,2), pw0); \
    VRD(4); SBAR(); GAPA(C1=__builtin_amdgcn_mfma_f32_32x32x16_bf16(kf[1],qr[0],C1,0,0,0), P0[6],P0[7],P0[8],P0[9],     pw0[2]=PKW(P0,4), pw0[3]=PKW(P0,6), pw0); \
    VRD(1); SBAR(); GAPA(C0=__builtin_amdgcn_mfma_f32_32x32x16_bf16(kf[2],qr[1],C0,0,0,0),   P0[10],P0[11],P0[12],P0[13], pw1[0]=PKW(P0,8), pw1[1]=PKW(P0,10), pw1); \
    VRD(5); SBAR(); GAPA(C1=__builtin_amdgcn_mfma_f32_32x32x16_bf16(kf[3],qr[1],C1,0,0,0),   P0[14],P0[15],P1[0],P1[1],   pw1[2]=PKW(P0,12),pw1[3]=PKW(P0,14), pw1); \
    VRD(2); SBAR(); GAPA(C0=__builtin_amdgcn_mfma_f32_32x32x16_bf16(kf[4],qr[2],C0,0,0,0),   P1[2],P1[3],P1[4],P1[5],     pw2[0]=PKW(P1,0), pw2[1]=PKW(P1,2), pw2); \
    VRD(6); SBAR(); GAPA(C1=__builtin_amdgcn_mfma_f32_32x32x16_bf16(kf[5],qr[2],C1,0,0,0),   P1[6],P1[7],P1[8],P1[9],     pw2[2]=PKW(P1,4), pw2[3]=PKW(P1,6), pw2); \
    VRD(3); SBAR(); GAPA(C0=__builtin_amdgcn_mfma_f32_32x32x16_bf16(kf[6],qr[3],C0,0,0,0),   P1[10],P1[11],P1[12],P1[13], pw3[0]=PKW(P1,8), pw3[1]=PKW(P1,10), pw3); \
    VRD(7); SBAR(); GAPA(C1=__builtin_amdgcn_mfma_f32_32x32x16_bf16(kf[7],qr[3],C1,0,0,0),   P1[14],P1[15],0.f,0.f,       pw3[2]=PKW(P1,12),pw3[3]=PKW(P1,14), pw3); \
    l_reg+=sacc; \
    if(GK){DMA_K((t)+3,sl_cur);} if(GV){DMA_V((t)+1,sl_next);} \
    CMASK(C0,C1,t); \
    { float a=MX3(C0[0],C0[1],C1[0]),b=MX3(C0[2],C0[3],C1[1]); a=MX3(a,C1[2],C1[3]); \
      _Pragma("unroll") for(int r=4;r<16;r+=4){a=MX3(a,C0[r],C0[r+1]);b=MX3(b,C0[r+2],C0[r+3]);a=MX3(a,C1[r],C1[r+1]);b=MX3(b,C1[r+2],C1[r+3]);} \
      float rm=__builtin_fmaxf(a,b); { auto rr=__builtin_amdgcn_permlane32_swap(__float_as_uint(rm),__float_as_uint(rm),false,false); rm=__builtin_fmaxf(__uint_as_float(rr[0]),__uint_as_float(rr[1])); } \
      resc=false; \
      if(__builtin_expect(__any(rm>(float)THRL),0)){ const float dl=__builtin_fmaxf(rm,0.f); mhat+=dl; \
        _Pragma("unroll") for(int r=0;r<16;++r){C0[r]-=dl;C1[r]-=dl;} \
        qx=ref_frag(-mhat); \
        const float f=__builtin_amdgcn_exp2f(-dl); l_reg*=f; if(hi==0)wsf[r32]=f; resc=true; } } \
    SBAR(); \
    GAPB(o[0]=__builtin_amdgcn_mfma_f32_32x32x16_bf16(PAF(0),VFR(0),o[0],0,0,0), C0,0); \
    GAPB(o[1]=__builtin_amdgcn_mfma_f32_32x32x16_bf16(PAF(0),VFR(4),o[1],0,0,0), C0,4); \
    KRD(GL,0); GAPB(o[0]=__builtin_amdgcn_mfma_f32_32x32x16_bf16(PAF(1),VFR(1),o[0],0,0,0), C0,8); \
    KRD(GL,1); GAPB(o[1]=__builtin_amdgcn_mfma_f32_32x32x16_bf16(PAF(1),VFR(5),o[1],0,0,0), C0,12); \
    KRD(GL,2); GAPB(o[0]=__builtin_amdgcn_mfma_f32_32x32x16_bf16(PAF(2),VFR(2),o[0],0,0,0), C1,0); \
    KRD(GL,3); GAPB(o[1]=__builtin_amdgcn_mfma_f32_32x32x16_bf16(PAF(2),VFR(6),o[1],0,0,0), C1,4); \
    GAPB(o[0]=__builtin_amdgcn_mfma_f32_32x32x16_bf16(PAF(3),VFR(3),o[0],0,0,0), C1,8); \
    GAPB(o[1]=__builtin_amdgcn_mfma_f32_32x32x16_bf16(PAF(3),VFR(7),o[1],0,0,0), C1,12); \
    }while(0)
  int t=1;
  #undef CMASK
  #define CMASK(P0,P1,t) do{}while(0)
  for(;t+5<NT;t+=2){
    STEP(pB0,pB1,pA0,pA1,t,true,true,true);     WAIT_BAR(2); RESC(); ROT();
    STEP(pA0,pA1,pB0,pB1,t+1,true,true,true);   WAIT_BAR(2); RESC(); ROT();
  }
  #undef CMASK
  #define CMASK(P0,P1,t) do{int jb_=(t)-(NT-4); if(jb_>=0)cmask(P0,P1,jb_,qrel,hi);}while(0)
  #define ENDW(tt) do{ if((tt)+3<NT){WAIT_BAR(2);} else if((tt)+2<NT){WAIT_BAR(1);} else {WAIT_BAR(0);} }while(0)
  for(;t+1<NT;t+=2){
    STEP(pB0,pB1,pA0,pA1,t,(t+3<NT),(t+1<NT),(t+1<NT));       ENDW(t);   RESC(); ROT();
    STEP(pA0,pA1,pB0,pB1,t+1,(t+4<NT),(t+2<NT),(t+2<NT));     ENDW(t+1); RESC(); ROT();
  }
  STEP(pB0,pB1,pA0,pA1,NT-1,false,false,false); RESC();
  { float sacc=pB0[0]+pB0[1]; _Pragma("unroll") for(int r=2;r<16;++r)sacc+=pB0[r]; _Pragma("unroll") for(int r=0;r<16;++r)sacc+=pB1[r]; l_reg+=sacc;
    pw0=(u32x4){PKW(pB0,0),PKW(pB0,2),PKW(pB0,4),PKW(pB0,6)};pw1=(u32x4){PKW(pB0,8),PKW(pB0,10),PKW(pB0,12),PKW(pB0,14)};pw2=(u32x4){PKW(pB1,0),PKW(pB1,2),PKW(pB1,4),PKW(pB1,6)};pw3=(u32x4){PKW(pB1,8),PKW(pB1,10),PKW(pB1,12),PKW(pB1,14)};
    SBAR(); pv(o,vb0+sl_cur,PAF(0),PAF(1),PAF(2),PAF(3)); }
  #undef PKW
  #undef PAF
  #undef VFR
  #undef PIN
  #undef MX3
  #undef GAPA
  #undef GAPB
  #undef EX
  #undef VRD
  #undef KRD
  #undef STEP
  #undef ENDW
  {auto rr=__builtin_amdgcn_permlane32_swap(__float_as_uint(l_reg),__float_as_uint(l_reg),false,false);l_reg=__uint_as_float(rr[0])+__uint_as_float(rr[1]);}
  if(hi==0)wsf[32+r32]=l_reg;asm volatile("s_waitcnt lgkmcnt(0)":::"memory");
  float rli[16];
  #pragma unroll
  for(int r=0;r<16;++r)rli[r]=__builtin_amdgcn_rcpf(wsf[32+crow(r,hi)]);
  bf16*Ow=Oh+(rowbase+q0+wid*QBLK)*(long)OP;
  { bf16*stg=(bf16*)(shm+LDS_OST)+wid*2048;
    #pragma unroll
    for(int r=0;r<16;++r){const int orow=crow(r,hi);
      #pragma unroll
      for(int d0=0;d0<2;++d0)stg[orow*64+d0*32+r32]=__float2bfloat16(o[d0][r]*rli[r]);}
    asm volatile("s_waitcnt lgkmcnt(0)":::"memory");
    #pragma unroll
    for(int i=0;i<4;++i){const int row=i*8+(lane>>3),ch=lane&7; const u32x4 v=*(const u32x4*)(stg+row*64+ch*8); ATTN_STORE16(Ow+(long)row*OP+ch*8,v);} }
  asm volatile("s_waitcnt lgkmcnt(0)\n\ts_barrier":::"memory");
  #undef DMA_K
  #undef DMA_V
  #undef CMASK
  #undef START
  #undef RESC
  #undef ROT
}
constexpr int ATTN_LDS_BYTES=LDS_BYTES;
#undef SBAR
#undef WAIT_BAR
}
namespace cg = cooperative_groups;
constexpr int NWAVES = 8;
#ifndef MK_NL
#define MK_NL 1
#endif
constexpr int N_PHASES = 20;
constexpr int BATCH = 4, SEQ = 4096, T = BATCH * SEQ, DM_ = 1024, FF = 4096, PLE = 256, ZW = 3072, WIN_LD = 3080, RW = 1280, RNB = 10;
constexpr float NORM_EPS = 1e-6f, SUBLN_EPS = 1e-5f, LOG2E = 1.4426950408889634f;
constexpr size_t MiB = 1u << 20;
constexpr size_t WS_WTS = 1 * MiB, WS_PBF = 29 * MiB, WS_LOGF = 37 * MiB, WS_CTAB = 37 * MiB + 512 * 1024, WS_SA = 38 * MiB, WS_SB = 39 * MiB + 512 * 1024, WS_AR = 41 * MiB;
constexpr size_t W_IN = 0, W_OUT = 6 * MiB, W_RIN = 0, W_RG = 5 * MiB, W_ROUT = 6 * MiB, W_UP = 9 * MiB, W_DOWN = 17 * MiB, W_PROJ = 25 * MiB, W_GATE = 25 * MiB + 512 * 1024;
constexpr size_t A_XA = 0, A_Z = 32 * MiB, A_OBUF = 128 * MiB, A_OD = 160 * MiB, A_EBUF = 160 * MiB, A_ACT = 32 * MiB, A_Y = 32 * MiB, A_XR = 72 * MiB, A_GA = 112 * MiB;
constexpr size_t WS_END = WS_AR + 192 * MiB;
static_assert(WS_END <= 256 * MiB, "d_ws map");
constexpr int RING_BYTES = 131072, LDS_BYTES = 147456;
static_assert(attn_body::ATTN_LDS_BYTES <= RING_BYTES, "attention LDS");

#define GAS __attribute__((address_space(1)))
#define LAS __attribute__((address_space(3)))
typedef unsigned short bf16;
typedef unsigned v4u __attribute__((ext_vector_type(4)));
typedef unsigned v2u __attribute__((ext_vector_type(2)));
typedef float f32x4 __attribute__((ext_vector_type(4)));
typedef short bf16x8 __attribute__((ext_vector_type(8)));
#define LDS_WAIT() asm volatile("s_waitcnt lgkmcnt(0)" ::: "memory")
__device__ __forceinline__ unsigned f2bf(float f) { unsigned u = __builtin_bit_cast(unsigned, f); return (u + 0x7fffu + ((u >> 16) & 1u)) >> 16; }
__device__ __forceinline__ unsigned pk2(float lo, float hi) { return f2bf(lo) | (f2bf(hi) << 16); }
__device__ __forceinline__ float bflo(unsigned w) { return __uint_as_float(w << 16); }
__device__ __forceinline__ float bfhi(unsigned w) { return __uint_as_float(w & 0xffff0000u); }
__device__ __forceinline__ float wave_sum(float v) {
#pragma unroll
    for (int o = 1; o < 64; o <<= 1) v += __shfl_xor(v, o);
    return v;
}
__device__ __forceinline__ float log_sigmoid_f(float v) { return v >= 0.f ? -log1pf(expf(-v)) : v - log1pf(expf(v)); }

struct Args { const float* in[28]; float* out; unsigned char* ws; int ph_lo, ph_hi; };
struct Frame {
    LAS unsigned char* lds; int tid, lane, wave, vcu, G;
    float* out; unsigned char* ws;
};
#define FIN(i) (args.in[i])
enum { I_X = 0, I_P, I_LN_MIX_PRE, I_LN_MIX_POST, I_LN_MLP_PRE, I_LN_MLP_POST, I_W_UP, I_W_DOWN, I_PLE_PROJ, I_PLE_NORM, I_PLE_GATE, I_ATT_WIN, I_ATT_BF, I_ATT_WOUT,
       I_LQ1, I_LK1, I_LQ2, I_LK2, I_SUBLN, I_REC_WIN, I_CONV_W, I_CONV_B, I_WX, I_BX, I_WA, I_BA, I_APARAM, I_REC_WOUT };

__device__ __forceinline__ void transpose_item(const float* W, int K, int ldw, int ncols, bf16* WT, int row_off, LAS float* scr, int item, int lane) {
    const int nblk = ncols / 32, kb = item / nblk, nb = item % nblk, k0 = 64 * kb, n0 = 32 * nb;
#pragma unroll 8
    for (int i = 0; i < 32; ++i) { const int kk = 2 * i + (lane >> 5); scr[kk * 33 + (lane & 31)] = W[(size_t)(k0 + kk) * ldw + n0 + (lane & 31)]; }
    LDS_WAIT(); asm volatile("" ::: "memory");
    const int c = lane & 7;
#pragma unroll
    for (int j = 0; j < 4; ++j) { const int n = (lane >> 3) + 8 * j; const LAS float* s = scr + (8 * c) * 33 + n;
        v4u o; o.x = pk2(s[0 * 33], s[1 * 33]); o.y = pk2(s[2 * 33], s[3 * 33]); o.z = pk2(s[4 * 33], s[5 * 33]); o.w = pk2(s[6 * 33], s[7 * 33]);
        *(GAS v4u*)(WT + (size_t)(row_off + n0 + n) * K + k0 + 8 * c) = o; }
    LDS_WAIT(); asm volatile("" ::: "memory");
}
__device__ __forceinline__ void convert_layer(const Args& args, Frame& F, int layer) {
    LAS float* scr = (LAS float*)(F.lds + F.wave * 16384);
    const int gw = F.vcu * NWAVES + F.wave, NGW = F.G * NWAVES;
    bf16* wt = (bf16*)(F.ws + WS_WTS);
    bf16 *Wup = (bf16*)((unsigned char*)wt + W_UP), *Wdown = (bf16*)((unsigned char*)wt + W_DOWN), *Wproj = (bf16*)((unsigned char*)wt + W_PROJ), *Wgate = (bf16*)((unsigned char*)wt + W_GATE);
    const float* wup = FIN(I_W_UP) + (size_t)layer * DM_ * FF; const float* wdown = FIN(I_W_DOWN) + (size_t)layer * FF * DM_;
    const float* wproj = FIN(I_PLE_PROJ) + (size_t)layer * PLE * DM_; const float* wgate = FIN(I_PLE_GATE) + (size_t)layer * DM_ * DM_;
    constexpr int I_UP = (DM_ / 64) * (FF / 32), I_DN = (FF / 64) * (DM_ / 32), I_PJ = (PLE / 64) * (DM_ / 32), I_GT = (DM_ / 64) * (DM_ / 32);
    constexpr int I_COMMON = I_UP + I_DN + I_PJ + I_GT;
    constexpr int I_AIN = (DM_ / 64) * (ZW / 32), I_AOUT = (DM_ / 64) * (DM_ / 32);
    constexpr int I_RIN = (DM_ / 64) * (2 * RW / 32), I_RG1 = (128 / 64) * (128 / 32), I_RG = RNB * I_RG1, I_ROUT = (RW / 64) * (DM_ / 32);
    const int nitems = I_COMMON + (layer == 0 ? I_AIN + I_AOUT : I_RIN + 2 * I_RG + I_ROUT);
    for (int it = gw; it < nitems; it += NGW) {
        int r = it;
        if (r < I_UP) { transpose_item(wup, DM_, FF, FF, Wup, 0, scr, r, F.lane); continue; } r -= I_UP;
        if (r < I_DN) { transpose_item(wdown, FF, DM_, DM_, Wdown, 0, scr, r, F.lane); continue; } r -= I_DN;
        if (r < I_PJ) { transpose_item(wproj, PLE, DM_, DM_, Wproj, 0, scr, r, F.lane); continue; } r -= I_PJ;
        if (r < I_GT) { transpose_item(wgate, DM_, DM_, DM_, Wgate, 0, scr, r, F.lane); continue; } r -= I_GT;
        if (layer == 0) {
            if (r < I_AIN) { transpose_item(FIN(I_ATT_WIN), DM_, WIN_LD, ZW, (bf16*)((unsigned char*)wt + W_IN), 0, scr, r, F.lane); continue; } r -= I_AIN;
            transpose_item(FIN(I_ATT_WOUT), DM_, DM_, DM_, (bf16*)((unsigned char*)wt + W_OUT), 0, scr, r, F.lane);
        } else {
            if (r < I_RIN) { transpose_item(FIN(I_REC_WIN), DM_, 2 * RW, 2 * RW, (bf16*)((unsigned char*)wt + W_RIN), 0, scr, r, F.lane); continue; } r -= I_RIN;
            if (r < I_RG) { const int n = r / I_RG1; transpose_item(FIN(I_WX) + (size_t)n * 128 * 128, 128, 128, 128, (bf16*)((unsigned char*)wt + W_RG) + (size_t)n * 256 * 128, 0, scr, r % I_RG1, F.lane); continue; } r -= I_RG;
            if (r < I_RG) { const int n = r / I_RG1; transpose_item(FIN(I_WA) + (size_t)n * 128 * 128, 128, 128, 128, (bf16*)((unsigned char*)wt + W_RG) + (size_t)n * 256 * 128, 128, scr, r % I_RG1, F.lane); continue; } r -= I_RG;
            transpose_item(FIN(I_REC_WOUT), RW, DM_, DM_, (bf16*)((unsigned char*)wt + W_ROUT), 0, scr, r, F.lane);
        }
    }
    const GAS f32x4* ps = (const GAS f32x4*)(FIN(I_P) + (size_t)layer * T * PLE); GAS v2u* pd = (GAS v2u*)(F.ws + WS_PBF);
    for (int i = blockIdx.x * (NWAVES * 64) + F.tid; i < T * PLE / 4; i += F.G * NWAVES * 64) { const f32x4 v = ps[i]; v2u o; o.x = pk2(v.x, v.y); o.y = pk2(v.z, v.w); pd[i] = o; }
}

__device__ __forceinline__ void ld_row_f32(const float* row, int lane, f32x4 (&v)[4]) { const GAS f32x4* p = (const GAS f32x4*)row + lane;
#pragma unroll
    for (int j = 0; j < 4; ++j) v[j] = p[64 * j]; }
__device__ __forceinline__ void ld_row_bf16(const bf16* row, int lane, f32x4 (&v)[4]) { const GAS v2u* p = (const GAS v2u*)row + lane;
#pragma unroll
    for (int j = 0; j < 4; ++j) { const v2u w = p[64 * j]; v[j] = (f32x4){bflo(w.x), bfhi(w.x), bflo(w.y), bfhi(w.y)}; } }
__device__ __forceinline__ void st_row_f32(float* row, int lane, const f32x4 (&v)[4]) { GAS f32x4* p = (GAS f32x4*)row + lane;
#pragma unroll
    for (int j = 0; j < 4; ++j) p[64 * j] = v[j]; }
__device__ __forceinline__ void st_row_bf16(bf16* row, int lane, const f32x4 (&v)[4]) { GAS v2u* p = (GAS v2u*)row + lane;
#pragma unroll
    for (int j = 0; j < 4; ++j) { v2u o; o.x = pk2(v[j].x, v[j].y); o.y = pk2(v[j].z, v[j].w); p[64 * j] = o; } }
__device__ __forceinline__ float row_rstd(const f32x4 (&v)[4], float eps) { float s = 0.f;
#pragma unroll
    for (int j = 0; j < 4; ++j) s += (v[j].x * v[j].x + v[j].y * v[j].y) + (v[j].z * v[j].z + v[j].w * v[j].w);
    return 1.0f / sqrtf(wave_sum(s) * (1.0f / 1024.0f) + eps); }

__device__ __forceinline__ void rowpass_pre0(const Args& args, Frame& F) {
    LAS float* fzw = (LAS float*)F.lds;
    const float* win = FIN(I_ATT_WIN);
    for (int i = F.tid; i < 8192; i += NWAVES * 64) { const int k = i >> 3, jj = i & 7; fzw[jj * 1024 + k] = win[(size_t)k * WIN_LD + ZW + jj]; }
    __syncthreads();
    const int gw = F.vcu * NWAVES + F.wave, NGW = F.G * NWAVES;
    bf16* XA = (bf16*)(F.ws + WS_AR + A_XA); float* logf = (float*)(F.ws + WS_LOGF);
    f32x4 g[4]; ld_row_f32(FIN(I_LN_MIX_PRE), F.lane, g);
    const float bfj = FIN(I_ATT_BF)[F.lane & 7];
    for (int m = gw; m < T; m += NGW) {
        f32x4 v[4]; ld_row_f32(FIN(I_X) + (size_t)m * DM_, F.lane, v);
        const float r = row_rstd(v, NORM_EPS);
#pragma unroll
        for (int j = 0; j < 4; ++j) v[j] = v[j] * r * g[j];
        st_row_bf16(XA + (size_t)m * DM_, F.lane, v);
        float mine = 0.f;
#pragma unroll
        for (int jj = 0; jj < 8; ++jj) { float d = 0.f;
#pragma unroll
            for (int j = 0; j < 4; ++j) { const f32x4 w = *(const LAS f32x4*)(fzw + jj * 1024 + 256 * j + 4 * F.lane); d += (v[j].x * w.x + v[j].y * w.y) + (v[j].z * w.z + v[j].w * w.w); }
            d = wave_sum(d); if ((F.lane & 7) == jj) mine = d; }
        if (F.lane < 8) logf[(size_t)m * 8 + F.lane] = log_sigmoid_f(mine + bfj);
    }
}
template <bool HAS_M, bool NORM_OUT, bool HAS_E>
__device__ __forceinline__ void rowpass(Frame& F, const float* hsrc, float* hdst, const float* gpost, const float* gpre, const float* ge) {
    const int gw = F.vcu * NWAVES + F.wave, NGW = F.G * NWAVES;
    bf16* XA = (bf16*)(F.ws + WS_AR + A_XA); bf16* EB = (bf16*)(F.ws + WS_AR + A_EBUF);
    for (int m = gw; m < T; m += NGW) {
        f32x4 h[4]; ld_row_f32(hsrc + (size_t)m * DM_, F.lane, h);
        if (HAS_M) { f32x4 mm[4]; ld_row_bf16(XA + (size_t)m * DM_, F.lane, mm); const float r = row_rstd(mm, NORM_EPS); f32x4 g[4]; ld_row_f32(gpost, F.lane, g);
#pragma unroll
            for (int j = 0; j < 4; ++j) h[j] = h[j] + mm[j] * r * g[j];
            st_row_f32(hdst + (size_t)m * DM_, F.lane, h); }
        if (NORM_OUT) { const float r = row_rstd(h, NORM_EPS); f32x4 g[4]; ld_row_f32(gpre, F.lane, g);
#pragma unroll
            for (int j = 0; j < 4; ++j) h[j] = h[j] * r * g[j]; }
        st_row_bf16(XA + (size_t)m * DM_, F.lane, h);
        if (HAS_E) { f32x4 e[4]; ld_row_bf16(EB + (size_t)m * DM_, F.lane, e); const float r = row_rstd(e, NORM_EPS); f32x4 g[4]; ld_row_f32(ge, F.lane, g);
#pragma unroll
            for (int j = 0; j < 4; ++j) e[j] = e[j] * r * g[j];
            st_row_bf16(EB + (size_t)m * DM_, F.lane, e); }
    }
}
__device__ __forceinline__ void cumsum_phase(Frame& F) {
    LAS float* sm = (LAS float*)F.lds;
    const float* logf = (const float*)(F.ws + WS_LOGF); float* ctab = (float*)(F.ws + WS_CTAB);
    for (int s = blockIdx.x; s < BATCH * 8; s += F.G) {
        const int b = s >> 3, h = s & 7; float v[8]; float run = 0.f;
#pragma unroll
        for (int i = 0; i < 8; ++i) { run += logf[((size_t)b * SEQ + F.tid * 8 + i) * 8 + h]; v[i] = run; }
        float incl = run;
#pragma unroll
        for (int o = 1; o < 64; o <<= 1) { const float y = __shfl_up(incl, o); if (F.lane >= o) incl += y; }
        if (F.lane == 63) sm[F.wave] = incl;
        __syncthreads();
        float woff = 0.f;
        for (int w = 0; w < F.wave; ++w) woff += sm[w];
        const float excl = woff + incl - run;
#pragma unroll
        for (int i = 0; i < 8; ++i) ctab[(size_t)s * SEQ + F.tid * 8 + i] = -(excl + v[i]) * LOG2E;
        __syncthreads();
    }
}
__device__ __forceinline__ void diff_combine(const Args& args, Frame& F) {
    const int gw = F.vcu * NWAVES + F.wave, NGW = F.G * NWAVES;
    const bf16* O0 = (const bf16*)(F.ws + WS_AR + A_OD); const bf16* O1 = O0 + (size_t)T * 512; bf16* OB = (bf16*)(F.ws + WS_AR + A_OBUF);
    const float s1 = wave_sum(FIN(I_LQ1)[F.lane] * FIN(I_LK1)[F.lane]), s2 = wave_sum(FIN(I_LQ2)[F.lane] * FIN(I_LK2)[F.lane]);
    const float lam_init = 0.8f - 0.6f * 1.0f;
    const float lam = expf(s1) - expf(s2) + lam_init, post = 1.0f - lam_init;
    float sg[8];
#pragma unroll
    for (int e = 0; e < 8; ++e) sg[e] = FIN(I_SUBLN)[(F.lane & 15) * 8 + e] * post;
    for (int m = gw; m < T; m += NGW) {
        const v4u a = *(const GAS v4u*)(O0 + (size_t)m * 512 + F.lane * 8), b = *(const GAS v4u*)(O1 + (size_t)m * 512 + F.lane * 8);
        float d[8];
        d[0] = bflo(a.x) - lam * bflo(b.x); d[1] = bfhi(a.x) - lam * bfhi(b.x); d[2] = bflo(a.y) - lam * bflo(b.y); d[3] = bfhi(a.y) - lam * bfhi(b.y);
        d[4] = bflo(a.z) - lam * bflo(b.z); d[5] = bfhi(a.z) - lam * bfhi(b.z); d[6] = bflo(a.w) - lam * bflo(b.w); d[7] = bfhi(a.w) - lam * bfhi(b.w);
        float ss = 0.f;
#pragma unroll
        for (int e = 0; e < 8; ++e) ss += d[e] * d[e];
        ss += __shfl_xor(ss, 1); ss += __shfl_xor(ss, 2); ss += __shfl_xor(ss, 4); ss += __shfl_xor(ss, 8);
        const float r = 1.0f / sqrtf(ss * (1.0f / 128.0f) + SUBLN_EPS);
        v4u o; o.x = pk2(d[0] * r * sg[0], d[1] * r * sg[1]); o.y = pk2(d[2] * r * sg[2], d[3] * r * sg[3]); o.z = pk2(d[4] * r * sg[4], d[5] * r * sg[5]); o.w = pk2(d[6] * r * sg[6], d[7] * r * sg[7]);
        *(GAS v4u*)(OB + (size_t)m * DM_ + F.lane * 8) = o;
    }
}
__device__ __forceinline__ void attention_phase(Frame& F, char* lds) {
    using abf = attn_body::bf16;
    const abf* Z = (const abf*)(F.ws + WS_AR + A_Z); abf* OB = (abf*)(F.ws + WS_AR + A_OBUF); abf* OD = (abf*)(F.ws + WS_AR + A_OD);
    const float* ctab = (const float*)(F.ws + WS_CTAB);
    for (int it = 0; ; ++it) {
        const int p = F.vcu + (it >> 1) * F.G; if (p >= BATCH * 24 * 8) break;
        const int bvh = p >> 3, s = p & 7, b = bvh / 24, vh = bvh % 24;
        const abf *Qh, *Kh, *Vh; abf* Oh; int OP; const float* btab; float slope2;
        if (vh < 16) { const int h = vh >> 2, mcomp = (vh >> 1) & 1, vhalf = vh & 1;
            Qh = Z + h * 128 + mcomp * 64; Kh = Z + 512 + h * 128 + mcomp * 64; Vh = Z + 1024 + h * 128 + vhalf * 64;
            Oh = OD + (size_t)mcomp * T * 512 + h * 128 + vhalf * 64; OP = 512; btab = nullptr; slope2 = exp2f(-2.0f * (float)(h + 1)) * LOG2E;
        } else { const int h = vh - 16;
            Qh = Z + 1536 + h * 64; Kh = Z + 2048 + h * 64; Vh = Z + 2560 + h * 64; Oh = OB + 512 + h * 64; OP = DM_; btab = ctab + (size_t)(b * 8 + h) * SEQ; slope2 = 0.f; }
        attn_body::attn_unit<8>((long)b * SEQ, (it & 1) ? 15 - s : s, Qh, Kh, Vh, Oh, OP, btab, slope2, lds);
    }
}
template <bool FINAL>
__device__ __forceinline__ void rec_core(const Args& args, Frame& F) {
    LAS bf16* xcb = (LAS bf16*)(F.lds);
    LAS float* xcf = (LAS float*)(F.lds + 17408);
    LAS bf16* hst = (LAS bf16*)(F.lds + 17408 + 33792);
    const bf16* XR = (const bf16*)(F.ws + WS_AR + A_XR); const bf16* YB = (const bf16*)(F.ws + WS_AR + A_Y); bf16* GA = (bf16*)(F.ws + WS_AR + A_GA);
    const bf16* WG = (const bf16*)(F.ws + WS_WTS + W_RG);
    float* SA = (float*)(F.ws + WS_SA); float* SB = (float*)(F.ws + WS_SB);
    const float *cw = FIN(I_CONV_W), *cb = FIN(I_CONV_B);
    const int tid = F.tid, lane = F.lane, w = F.wave, fr = lane & 15, fq = lane >> 4;
    for (int it = blockIdx.x; it < BATCH * 64 * RNB; it += F.G) {
        const int n = it % RNB, k = (it / RNB) % 64, b = it / (RNB * 64);
        const size_t trow0 = (size_t)b * SEQ + (size_t)k * 64;
#pragma unroll
        for (int q = 0; q < 2; ++q) {
            const int idx = tid + q * 512, r = idx >> 4, cgp = idx & 15, c0 = n * 128 + cgp * 8;
            f32x4 a0 = *(const GAS f32x4*)(cb + c0), a1 = *(const GAS f32x4*)(cb + c0 + 4);
#pragma unroll
            for (int j = 0; j < 4; ++j) { const int tt = k * 64 + r - 3 + j;
                if (tt >= 0) { const v4u xv = *(const GAS v4u*)(XR + ((size_t)b * SEQ + tt) * RW + c0);
                    const f32x4 w0 = *(const GAS f32x4*)(cw + j * RW + c0), w1 = *(const GAS f32x4*)(cw + j * RW + c0 + 4);
                    a0[0] += w0[0] * bflo(xv.x); a0[1] += w0[1] * bfhi(xv.x); a0[2] += w0[2] * bflo(xv.y); a0[3] += w0[3] * bfhi(xv.y);
                    a1[0] += w1[0] * bflo(xv.z); a1[1] += w1[1] * bfhi(xv.z); a1[2] += w1[2] * bflo(xv.w); a1[3] += w1[3] * bfhi(xv.w); } }
            *(LAS f32x4*)(xcf + r * 132 + cgp * 8) = a0; *(LAS f32x4*)(xcf + r * 132 + cgp * 8 + 4) = a1;
            v4u o; o.x = pk2(a0[0], a0[1]); o.y = pk2(a0[2], a0[3]); o.z = pk2(a1[0], a1[1]); o.w = pk2(a1[2], a1[3]);
            *(LAS v4u*)(xcb + r * 136 + cgp * 8) = o;
        }
        __syncthreads();
        f32x4 ax[4], aa[4];
#pragma unroll
        for (int mt = 0; mt < 4; ++mt) { ax[mt] = (f32x4){0.f, 0.f, 0.f, 0.f}; aa[mt] = (f32x4){0.f, 0.f, 0.f, 0.f}; }
        const bf16* Bx = WG + ((size_t)n * 256 + 16 * w + fr) * 128 + 8 * fq; const bf16* Ba = Bx + 128 * 128;
#pragma unroll
        for (int kk = 0; kk < 4; ++kk) { const bf16x8 bx = *(const GAS bf16x8*)(Bx + 32 * kk), ba = *(const GAS bf16x8*)(Ba + 32 * kk);
#pragma unroll
            for (int mt = 0; mt < 4; ++mt) { const bf16x8 af = *(const LAS bf16x8*)(xcb + (16 * mt + fr) * 136 + 32 * kk + 8 * fq);
                ax[mt] = __builtin_amdgcn_mfma_f32_16x16x32_bf16(af, bx, ax[mt], 0, 0, 0); aa[mt] = __builtin_amdgcn_mfma_f32_16x16x32_bf16(af, ba, aa[mt], 0, 0, 0); } }
        const int cl = 16 * w + fr, c = n * 128 + cl;
        const float bxv = FIN(I_BX)[c], bav = FIN(I_BA)[c], ls8 = 8.0f * log_sigmoid_f(FIN(I_APARAM)[c]);
        float Hin = 0.f, Ac = 1.f, Bc = 0.f;
        if (FINAL) {
            float sa[16], sb[16];
#pragma unroll
            for (int j = 0; j < 16; ++j) { const int jc = 16 * fq + j; const size_t o = ((size_t)b * 64 + jc) * RW + c; const bool ok = jc < k; sa[j] = ok ? SA[o] : 1.f; sb[j] = ok ? SB[o] : 0.f; }
            float A = 1.f, B = 0.f;
#pragma unroll
            for (int j = 0; j < 16; ++j) { B = sa[j] * B + sb[j]; A = A * sa[j]; }
            { const float A1 = __shfl_up(A, 16), B1 = __shfl_up(B, 16); if (fq >= 1) { B = A * B1 + B; A = A1 * A; } }
            { const float A2 = __shfl_up(A, 32), B2 = __shfl_up(B, 32); if (fq >= 2) { B = A * B2 + B; A = A2 * A; } }
            Hin = __shfl(B, fr + 48);
        }
#pragma unroll
        for (int mt = 0; mt < 4; ++mt) {
            float cA[4], hl[4];
#pragma unroll
            for (int i = 0; i < 4; ++i) { const int tl = 16 * mt + 4 * fq + i;
                const float gx = 1.0f / (1.0f + expf(-(ax[mt][i] + bxv))), ga = 1.0f / (1.0f + expf(-(aa[mt][i] + bav)));
                const float la = ls8 * ga, a = expf(la); float mult = sqrtf(-expm1f(2.0f * la)); if (k == 0 && tl == 0) mult = 1.0f;
                const float bb = mult * gx * xcf[tl * 132 + cl];
                if (i == 0) { cA[0] = a; hl[0] = bb; } else { cA[i] = cA[i - 1] * a; hl[i] = a * hl[i - 1] + bb; } }
            float A = cA[3], B = hl[3];
            { const float A1 = __shfl_up(A, 16), B1 = __shfl_up(B, 16); if (fq >= 1) { B = A * B1 + B; A = A1 * A; } }
            { const float A2 = __shfl_up(A, 32), B2 = __shfl_up(B, 32); if (fq >= 2) { B = A * B2 + B; A = A2 * A; } }
            float Ae = __shfl_up(A, 16), Be = __shfl_up(B, 16); if (fq == 0) { Ae = 1.f; Be = 0.f; }
            const float At = __shfl(A, fr + 48), Bt = __shfl(B, fr + 48);
            if (FINAL) { const float hen = Ae * Hin + Be;
#pragma unroll
                for (int i = 0; i < 4; ++i) { const float hv = cA[i] * hen + hl[i]; hst[(16 * mt + 4 * fq + i) * 136 + cl] = (bf16)f2bf(hv); }
                Hin = At * Hin + Bt;
            } else { Bc = At * Bc + Bt; Ac = Ac * At; }
        }
        if (!FINAL) { if (fq == 0) { const size_t o = ((size_t)b * 64 + k) * RW + c; SA[o] = Ac; SB[o] = Bc; } __syncthreads(); }
        else {
            __syncthreads();
#pragma unroll
            for (int q = 0; q < 2; ++q) { const int idx = tid + q * 512, r = idx >> 4, cgp = idx & 15; const size_t go = (trow0 + r) * RW + n * 128 + cgp * 8;
                const v4u hv = *(const LAS v4u*)(hst + r * 136 + cgp * 8); const v4u yv = *(const GAS v4u*)(YB + go);
                v4u o; o.x = pk2(bflo(hv.x) * bflo(yv.x), bfhi(hv.x) * bfhi(yv.x)); o.y = pk2(bflo(hv.y) * bflo(yv.y), bfhi(hv.y) * bfhi(yv.y));
                o.z = pk2(bflo(hv.z) * bflo(yv.z), bfhi(hv.z) * bfhi(yv.z)); o.w = pk2(bflo(hv.w) * bflo(yv.w), bfhi(hv.w) * bfhi(yv.w));
                *(GAS v4u*)(GA + go) = o; }
        }
    }
}

template <int MODE> __device__ __forceinline__ void run_gemm(Frame& F, const bf16* A, const bf16* Bt, int N, int K, const pg8::EpiX<MODE>& E) {
    pg8::Gemm g{A, Bt, T, N, K}; pg8::StaticOrder S; S.init(T, N, F.G, (int)blockIdx.x);
    pg8::gemm_phase<pg8::EpiX<MODE>, pg8::StaticOrder, true, true>(F.lds, g, S, E);
}
__global__ void __launch_bounds__(NWAVES * 64, 2) fwd_mega(Args args) {
    extern __shared__ __attribute__((aligned(16))) unsigned char lds[];
    Frame F;
    F.lds = (LAS unsigned char*)lds; F.tid = threadIdx.x; F.lane = F.tid & 63; F.wave = __builtin_amdgcn_readfirstlane(F.tid >> 6);
#define PHASE_BEGIN() do { F.tid = pg8::otid(); F.lane = F.tid & 63; F.wave = __builtin_amdgcn_readfirstlane(F.tid >> 6); } while (0)
    F.G = gridDim.x; { const int bx = blockIdx.x; F.vcu = (F.G % 8 == 0) ? (bx % 8) * (F.G / 8) + bx / 8 : bx; }
#pragma unroll
    for (int i = 0; i < 28; ++i) FIN(i) = args.in[i];
    F.out = args.out; F.ws = args.ws;
    const int lo = args.ph_lo, hi = args.ph_hi;
#ifndef PH_MASK
#define PH_MASK 0xFFFFFu
#endif
#define IN(k) (((PH_MASK >> (k)) & 1u) && lo <= (k) && (k) < hi)
#define SEAM(k) do { if (IN(k) && IN((k) + 1)) { cg::this_grid().sync(); } } while (0)
    unsigned char* ws = args.ws; unsigned char* wt = ws + WS_WTS; unsigned char* ar = ws + WS_AR;
    bf16* XA = (bf16*)(ar + A_XA); bf16* EB = (bf16*)(ar + A_EBUF); const bf16* PBF = (const bf16*)(ws + WS_PBF);

    for (int layer = 0; layer < 2; ++layer) {
        const int pb = layer * 10;
        const float* g_mix_post = FIN(I_LN_MIX_POST) + layer * DM_; const float* g_mlp_pre = FIN(I_LN_MLP_PRE) + layer * DM_;
        const float* g_mlp_post = FIN(I_LN_MLP_POST) + layer * DM_; const float* g_ple = FIN(I_PLE_NORM) + layer * DM_;
        if (layer == 0) {
            if (IN(0)) { PHASE_BEGIN(); convert_layer(args, F, 0); __syncthreads(); rowpass_pre0(args, F); } SEAM(0);
            if (IN(1)) { PHASE_BEGIN(); cumsum_phase(F); __syncthreads();
                pg8::EpiX<0> E{(bf16*)(ar + A_Z), ZW, attn_body::C2, 0xC3u, nullptr, nullptr, nullptr}; run_gemm<0>(F, XA, (const bf16*)(wt + W_IN), ZW, DM_, E); } SEAM(1);
            if (IN(2)) { PHASE_BEGIN(); attention_phase(F, (char*)lds); } SEAM(2);
            if (IN(3)) { PHASE_BEGIN(); diff_combine(args, F); } SEAM(3);
            if (IN(4)) { PHASE_BEGIN(); { pg8::EpiX<0> E{XA, DM_, 1.f, 0u, nullptr, nullptr, nullptr}; run_gemm<0>(F, (const bf16*)(ar + A_OBUF), (const bf16*)(wt + W_OUT), DM_, DM_, E); }
                         { pg8::EpiX<0> E{EB, DM_, 1.f, 0u, nullptr, nullptr, nullptr}; run_gemm<0>(F, PBF, (const bf16*)(wt + W_PROJ), DM_, PLE, E); } } SEAM(4);
        } else {
            if (IN(10)) { PHASE_BEGIN(); convert_layer(args, F, 1); rowpass<false, true, false>(F, F.out, nullptr, nullptr, FIN(I_LN_MIX_PRE) + DM_, nullptr); } SEAM(10);
            if (IN(11)) { PHASE_BEGIN(); pg8::EpiX<2> E{(bf16*)(ar + A_Y), RW, 1.f, 0u, (bf16*)(ar + A_XR), nullptr, nullptr}; run_gemm<2>(F, XA, (const bf16*)(wt + W_RIN), 2 * RW, DM_, E); } SEAM(11);
            if (IN(12)) { PHASE_BEGIN(); rec_core<false>(args, F); } SEAM(12);
            if (IN(13)) { PHASE_BEGIN(); rec_core<true>(args, F); } SEAM(13);
            if (IN(14)) { PHASE_BEGIN(); { pg8::EpiX<0> E{XA, DM_, 1.f, 0u, nullptr, nullptr, nullptr}; run_gemm<0>(F, (const bf16*)(ar + A_GA), (const bf16*)(wt + W_ROUT), DM_, RW, E); }
                          { pg8::EpiX<0> E{EB, DM_, 1.f, 0u, nullptr, nullptr, nullptr}; run_gemm<0>(F, PBF, (const bf16*)(wt + W_PROJ), DM_, PLE, E); } } SEAM(14);
        }
        if (IN(pb + 5)) { PHASE_BEGIN(); rowpass<true, true, true>(F, layer == 0 ? FIN(I_X) : (const float*)F.out, F.out, g_mix_post, g_mlp_pre, g_ple); } SEAM(pb + 5);
        if (IN(pb + 6)) { PHASE_BEGIN(); pg8::EpiX<1> E{(bf16*)(ar + A_ACT), FF, 1.f, 0u, nullptr, nullptr, nullptr}; run_gemm<1>(F, XA, (const bf16*)(wt + W_UP), FF, DM_, E); } SEAM(pb + 6);
        if (IN(pb + 7)) { PHASE_BEGIN(); pg8::EpiX<0> E{XA, DM_, 1.f, 0u, nullptr, nullptr, nullptr}; run_gemm<0>(F, (const bf16*)(ar + A_ACT), (const bf16*)(wt + W_DOWN), DM_, FF, E); } SEAM(pb + 7);
        if (IN(pb + 8)) { PHASE_BEGIN(); rowpass<true, false, false>(F, F.out, F.out, g_mlp_post, nullptr, nullptr); } SEAM(pb + 8);
        if (IN(pb + 9)) { PHASE_BEGIN(); pg8::EpiX<3> E{nullptr, DM_, 1.f, 0u, nullptr, F.out, EB}; run_gemm<3>(F, XA, (const bf16*)(wt + W_GATE), DM_, DM_, E); } SEAM(pb + 9);
    }
#undef IN
#undef SEAM
}

extern "C" void kernel_launch(void* const* d_in, const int* in_sizes, int n_in, void* d_out, int out_size, void* d_ws, size_t ws_size, hipStream_t stream) {
    static int grid = 0;
    if (grid == 0) {
        if (n_in != 28 || out_size != T * DM_ || ws_size < WS_END) { fprintf(stderr, "kernel_launch: unexpected shapes: n_in %d out %d ws %zu\n", n_in, out_size, ws_size); grid = -1; return; }
        int dev = 0, cus = 0, per_cu = 0;
        if (hipGetDevice(&dev) != hipSuccess || hipDeviceGetAttribute(&cus, hipDeviceAttributeMultiprocessorCount, dev) != hipSuccess) { grid = -1; return; }
        if (hipFuncSetAttribute((const void*)fwd_mega, hipFuncAttributeMaxDynamicSharedMemorySize, LDS_BYTES) != hipSuccess) { fprintf(stderr, "kernel_launch: hipFuncSetAttribute failed\n"); grid = -1; return; }
        if (hipOccupancyMaxActiveBlocksPerMultiprocessor(&per_cu, (const void*)fwd_mega, NWAVES * 64, LDS_BYTES) != hipSuccess || per_cu < 1) { fprintf(stderr, "kernel_launch: occupancy query says %d\n", per_cu); per_cu = 1; }
        (void)hipGetLastError();
        grid = cus * 1;
        fprintf(stderr, "kernel_launch: grid %d (cus %d, per_cu %d)\n", grid, cus, per_cu);
    }
    if (grid < 0) return;
    Args a{};
    for (int i = 0; i < 28; ++i) a.in[i] = (const float*)d_in[i];
    a.out = (float*)d_out; a.ws = (unsigned char*)d_ws;
#if MK_NL == 1
    a.ph_lo = 0; a.ph_hi = N_PHASES;
    void* kargs[] = {(void*)&a};
    hipError_t e = hipLaunchCooperativeKernel((const void*)fwd_mega, dim3(grid), dim3(NWAVES * 64), kargs, LDS_BYTES, stream);
    if (e != hipSuccess) fprintf(stderr, "kernel_launch: cooperative launch failed: %s (grid %d)\n", hipGetErrorString(e), grid);
#else
    for (int ph = 0; ph < N_PHASES; ++ph) { a.ph_lo = ph; a.ph_hi = ph + 1; hipLaunchKernelGGL(fwd_mega, dim3(grid), dim3(NWAVES * 64), LDS_BYTES, stream, a); }
#endif
}
```

```cpp
#include <hip/hip_runtime.h>
#include <hip/hip_cooperative_groups.h>
#include <cstdio>
#include <cstdint>
namespace pg8 {
#define PG8_LAS __attribute__((address_space(3)))
typedef unsigned short bf16_t;
typedef short bf16x8 __attribute__((ext_vector_type(8)));
typedef float f32x4 __attribute__((ext_vector_type(4)));
typedef unsigned u32x4 __attribute__((ext_vector_type(4)));
constexpr int BM = 256, BK = 64, HALF = 128, HTB = HALF * BK * 2  , STAGE_BYTES = 8 * HTB, NXCD = 8, WGM = 8;

__host__ __device__ __forceinline__ int lds_byte(int r, int c) { const int st = (r >> 4) * 2 + (c >> 5), rr = r & 15, cc = c & 31, ob = rr * 64 + cc * 2; return st * 1024 + (ob ^ (((ob >> 9) & 1) << 5)); }
__host__ __device__ __forceinline__ void stage_rc(int b, int& R, int& C) { const int st = b / 1024, sb = b % 1024, swz = sb ^ (((sb >> 9) & 1) << 5); R = (st >> 1) * 16 + swz / 64; C = (st & 1) * 32 + (swz % 64) / 2; }
__host__ __device__ __forceinline__ int perm32(int rho) { const int n = rho >> 4, i = rho & 15; return 8 * (i >> 2) + 4 * n + (i & 3); }

__device__ __forceinline__ int otid() { int t = threadIdx.x; asm volatile("" : "+v"(t)); return t; }
struct Unit { int pm, pn; };
struct Gemm { const bf16_t* A; const bf16_t* Bt; int M, N, K; };

struct StaticOrder {
    int nM, nN, nwg, G, c;
    __host__ __device__ void init(int M, int N, int G_, int c_) { nM = M / BM; nN = N / BM; nwg = nM * nN; G = G_; c = c_; }
    __host__ __device__ bool next(int i, Unit& u) const {
        const long L = (long)i * G + c; if (L >= nwg) return false;
        int wgid = (int)L; { const int q = nwg / NXCD, r = nwg % NXCD, xcd = wgid % NXCD, off = wgid / NXCD; wgid = (xcd < r ? xcd * (q + 1) : r * (q + 1) + (xcd - r) * q) + off; }
        const int nig = WGM * nN, gid = wgid / nig, fm = gid * WGM, gsz = (nM - fm) < WGM ? (nM - fm) : WGM;
        u.pm = fm + ((wgid % nig) % gsz); u.pn = (wgid % nig) / gsz; return true;
    }
    __device__ __forceinline__ void a_ready(const Unit&) const {}
    __device__ __forceinline__ void done(const Unit&) const {}
};

__device__ __forceinline__ unsigned cvt_pk_bf16(float lo, float hi) { unsigned r; asm volatile("v_cvt_pk_bf16_f32 %0, %1, %2" : "=v"(r) : "v"(lo), "v"(hi)); return r; }
typedef float f32x2 __attribute__((ext_vector_type(2)));
__device__ __forceinline__ float bf_lo(unsigned w) { return __uint_as_float(w << 16); }
__device__ __forceinline__ float bf_hi(unsigned w) { return __uint_as_float(w & 0xffff0000u); }
__device__ __forceinline__ float sigmoid_f(float v) { return __builtin_amdgcn_rcpf(1.0f + __builtin_amdgcn_exp2f(-1.4426950408889634f * v)); }
__device__ __forceinline__ float gelu_tanh_f(float v) { const float z = 1.5957691216057308f * (v + 0.044715f * v * v * v); return v * sigmoid_f(z); }
template <int MODE> struct EpiX {
    static constexpr bool PERM = true, AFTER_DRAIN = false;
    bf16_t* O; int ldc; float scale0; unsigned scale_mask; bf16_t* O2; float* H; const bf16_t* E;
    __device__ __forceinline__ void operator()(const f32x4 (&acc)[2][2][4][2], const Unit& u, int wr, int wc, int fr, int fq) const {
        const int row0 = u.pm * BM + wr * 64 + fr; const int col0 = u.pn * BM + wc * 32 + 8 * fq;
        float sc = 1.f; if (MODE == 0) sc = ((scale_mask >> u.pn) & 1u) ? scale0 : 1.f;
#pragma unroll
        for (int ai = 0; ai < 2; ++ai)
#pragma unroll
            for (int m = 0; m < 4; ++m) { const size_t row = (size_t)(row0 + ai * HALF + m * 16);
#pragma unroll
                for (int bj = 0; bj < 2; ++bj) { f32x4 v0 = acc[ai][bj][m][0], v1 = acc[ai][bj][m][1]; const int col = col0 + bj * HALF;
                    if (MODE == 3) {
                        float* hp = H + row * ldc + col; const u32x4 ev = *(const u32x4*)(E + row * ldc + col);
                        f32x4 h0 = *(const f32x4*)hp, h1 = *(const f32x4*)(hp + 4);
                        h0[0] += bf_lo(ev.x) * sigmoid_f(v0[0]); h0[1] += bf_hi(ev.x) * sigmoid_f(v0[1]); h0[2] += bf_lo(ev.y) * sigmoid_f(v0[2]); h0[3] += bf_hi(ev.y) * sigmoid_f(v0[3]);
                        h1[0] += bf_lo(ev.z) * sigmoid_f(v1[0]); h1[1] += bf_hi(ev.z) * sigmoid_f(v1[1]); h1[2] += bf_lo(ev.w) * sigmoid_f(v1[2]); h1[3] += bf_hi(ev.w) * sigmoid_f(v1[3]);
                        *(f32x4*)hp = h0; *(f32x4*)(hp + 4) = h1;
                    } else {
                        bf16_t* dst = O + row * ldc + col;
                        if (MODE == 0) { v0 = v0 * sc; v1 = v1 * sc; }
                        if (MODE == 1) {
#pragma unroll
                            for (int e = 0; e < 4; ++e) { const float a = __builtin_fmaxf(v0[e], 0.f), b = __builtin_fmaxf(v1[e], 0.f); v0[e] = a * a; v1[e] = b * b; } }
                        if (MODE == 2) { if (u.pn < 5) {
#pragma unroll
                            for (int e = 0; e < 4; ++e) { v0[e] = gelu_tanh_f(v0[e]); v1[e] = gelu_tanh_f(v1[e]); } } else dst = O2 + row * ldc + (col - 1280); }
                        u32x4 w; w.x = cvt_pk_bf16(v0[0], v0[1]); w.y = cvt_pk_bf16(v0[2], v0[3]); w.z = cvt_pk_bf16(v1[0], v1[1]); w.w = cvt_pk_bf16(v1[2], v1[3]);
                        *(u32x4*)dst = w;
                    } } }
    }
};

template <class Epi, class Sched, bool ALIGN_EPI = false, bool SP2 = false>
__device__ __forceinline__ void gemm_phase(PG8_LAS unsigned char* lds, const Gemm g, const Sched& S, const Epi& E) {
    const int tid = otid(), wid = __builtin_amdgcn_readfirstlane(tid >> 6), lane = tid & 63, wr = wid >> 2, wc = wid & 3, fr = lane & 15, fq = lane >> 4;
    const int K = g.K, nt = K / BK;
    unsigned voffA[2], voffB[2];
#pragma unroll
    for (int i = 0; i < 2; ++i) { int R, C; stage_rc(tid * 16 + i * 8192, R, C); const int Rb = Epi::PERM ? ((R & ~31) + perm32(R & 31)) : R;
        voffA[i] = (unsigned)(R * K + C) * 2u; voffB[i] = (unsigned)(Rb * K + C) * 2u; }
    const size_t kstep = (size_t)(BK * 2);
    const size_t hstep = (size_t)HALF * K * 2;
    const size_t tstep = 2 * hstep;
    const unsigned ldsw = (unsigned)wid * 1024u;
    const int aoff = lds_byte(wr * 64 + fr, fq * 8), boff = lds_byte(wc * 32 + fr, fq * 8);
#define PG8_SA(b, h) (((b) * 2 + (h)) * HTB)
#define PG8_SB(b, h) ((4 + (b) * 2 + (h)) * HTB)
#define PG8_STAGE(bufoff, gbase, voff) do { _Pragma("unroll") for (int _i = 0; _i < 2; ++_i) \
        __builtin_amdgcn_global_load_lds((const unsigned*)((const char*)(gbase) + (voff)[_i]), (PG8_LAS unsigned*)(lds + (bufoff) + ldsw + _i * 8192), 16, 0, 0); } while (0)
#define PG8_LDA(dst, b, h) do { _Pragma("unroll") for (int m = 0; m < 4; ++m) _Pragma("unroll") for (int k = 0; k < 2; ++k) dst[m][k] = *(const PG8_LAS bf16x8*)(lds + PG8_SA(b, h) + aoff + m * 2048 + k * 1024); } while (0)
#define PG8_LDB(dst, b, h) do { _Pragma("unroll") for (int n = 0; n < 2; ++n) _Pragma("unroll") for (int k = 0; k < 2; ++k) dst[n][k] = *(const PG8_LAS bf16x8*)(lds + PG8_SB(b, h) + boff + n * 2048 + k * 1024); } while (0)
#define PG8_MMA(ai, bj, At, Bt) do { __builtin_amdgcn_s_setprio(1); _Pragma("unroll") for (int m = 0; m < 4; ++m) _Pragma("unroll") for (int n = 0; n < 2; ++n) _Pragma("unroll") for (int k = 0; k < 2; ++k) \
        acc[ai][bj][m][n] = __builtin_amdgcn_mfma_f32_16x16x32_bf16(Bt[n][k], At[m][k], acc[ai][bj][m][n], 0, 0, 0); __builtin_amdgcn_s_setprio(0); } while (0)
#define PG8_WAIT_V(n) asm volatile("s_waitcnt vmcnt(" #n ")" ::: "memory")
#define PG8_WAIT_L(n) asm volatile("s_waitcnt lgkmcnt(" #n ")" ::: "memory")
#define PG8_BAR __builtin_amdgcn_s_barrier()
#define PG8_SCHED __builtin_amdgcn_sched_barrier(0)
    Unit cur, nxt; int ui = 0;
    if (!S.next(0, cur)) return;
    f32x4 acc[2][2][4][2];
#pragma unroll
    for (int a = 0; a < 2; ++a)
#pragma unroll
        for (int b = 0; b < 2; ++b)
#pragma unroll
            for (int m = 0; m < 4; ++m)
#pragma unroll
                for (int n = 0; n < 2; ++n) acc[a][b][m][n] = (f32x4){0.f, 0.f, 0.f, 0.f};
    bf16x8 At[4][2], B0[2][2], B1[2][2];
    const char* cA = (const char*)g.A + (size_t)cur.pm * tstep; const char* cB = (const char*)g.Bt + (size_t)cur.pn * tstep;
    S.a_ready(cur);
    if constexpr (SP2) {
        PG8_STAGE(PG8_SB(0, 0), cB, voffB); PG8_STAGE(PG8_SB(0, 1), cB + hstep, voffB); PG8_STAGE(PG8_SA(0, 0), cA, voffA); PG8_STAGE(PG8_SA(0, 1), cA + hstep, voffA);
        if (wr == 1) PG8_BAR;
        PG8_WAIT_V(2); PG8_BAR;
        PG8_STAGE(PG8_SB(1, 0), cB + kstep, voffB); PG8_STAGE(PG8_SA(1, 0), cA + kstep, voffA); PG8_STAGE(PG8_SB(1, 1), cB + hstep + kstep, voffB);
        PG8_WAIT_V(6); PG8_BAR;
    } else {
        PG8_STAGE(PG8_SB(0, 0), cB, voffB); PG8_STAGE(PG8_SA(0, 0), cA, voffA); PG8_STAGE(PG8_SB(0, 1), cB + hstep, voffB); PG8_STAGE(PG8_SA(0, 1), cA + hstep, voffA);
        if (wr == 1) PG8_BAR;
        PG8_WAIT_V(4); PG8_BAR;
        PG8_STAGE(PG8_SB(1, 0), cB + kstep, voffB); PG8_STAGE(PG8_SA(1, 0), cA + kstep, voffA); PG8_STAGE(PG8_SB(1, 1), cB + hstep + kstep, voffB);
        PG8_WAIT_V(6); PG8_BAR;
    }
    for (;;) {
        const bool has_next = S.next(ui + 1, nxt);
        const char* nA = has_next ? (const char*)g.A + (size_t)nxt.pm * tstep : cA; const char* nB = has_next ? (const char*)g.Bt + (size_t)nxt.pn * tstep : cB;
        for (int t = 0; t < nt; t += 2) {
            const bool last = (t == nt - 2);
            const char* a1 = cA + (size_t)(t + 1) * kstep;
            const char* a2 = last ? nA : cA + (size_t)(t + 2) * kstep; const char* b2 = last ? nB : cB + (size_t)(t + 2) * kstep;
            const char* a3 = a2 + kstep; const char* b3 = b2 + kstep;
            if (last && has_next) S.a_ready(nxt);
            if constexpr (SP2) {
            PG8_LDB(B0, 0, 0); PG8_LDB(B1, 0, 1); PG8_SCHED; PG8_LDA(At, 0, 0); PG8_STAGE(PG8_SA(1, 1), a1 + hstep, voffA);
            PG8_WAIT_V(8); PG8_WAIT_L(0); PG8_BAR; PG8_MMA(0, 0, At, B0); PG8_MMA(0, 1, At, B1); PG8_BAR; PG8_SCHED;
            PG8_LDA(At, 0, 1); PG8_STAGE(PG8_SB(0, 0), b2, voffB); PG8_STAGE(PG8_SB(0, 1), b2 + hstep, voffB); PG8_STAGE(PG8_SA(0, 0), a2, voffA);
            PG8_WAIT_V(8); PG8_WAIT_L(0); PG8_BAR; PG8_MMA(1, 0, At, B0); PG8_MMA(1, 1, At, B1); PG8_BAR; PG8_SCHED;
            PG8_LDB(B0, 1, 0); PG8_LDB(B1, 1, 1); PG8_SCHED; PG8_LDA(At, 1, 0); PG8_STAGE(PG8_SA(0, 1), a2 + hstep, voffA);
            PG8_WAIT_V(8); PG8_WAIT_L(0); PG8_BAR; PG8_MMA(0, 0, At, B0); PG8_MMA(0, 1, At, B1); PG8_BAR; PG8_SCHED;
            PG8_LDA(At, 1, 1); PG8_STAGE(PG8_SB(1, 0), b3, voffB); PG8_STAGE(PG8_SB(1, 1), b3 + hstep, voffB); PG8_STAGE(PG8_SA(1, 0), a3, voffA);
            PG8_WAIT_V(8); PG8_WAIT_L(0); PG8_BAR; PG8_MMA(1, 0, At, B0); PG8_MMA(1, 1, At, B1); PG8_BAR; PG8_SCHED;
            } else {
            PG8_LDB(B0, 0, 0); PG8_SCHED; PG8_LDA(At, 0, 0); PG8_STAGE(PG8_SA(1, 1), a1 + hstep, voffA);
            PG8_WAIT_L(8); PG8_BAR; PG8_WAIT_L(0); PG8_MMA(0, 0, At, B0); PG8_BAR; PG8_SCHED;
            PG8_LDB(B1, 0, 1); PG8_STAGE(PG8_SB(0, 0), b2, voffB);
            PG8_BAR; PG8_WAIT_L(0); PG8_MMA(0, 1, At, B1); PG8_BAR;
            PG8_LDA(At, 0, 1); PG8_STAGE(PG8_SA(0, 0), a2, voffA);
            PG8_BAR; PG8_WAIT_L(0); PG8_MMA(1, 0, At, B0); PG8_BAR; PG8_SCHED;
            PG8_STAGE(PG8_SB(0, 1), b2 + hstep, voffB);
            PG8_WAIT_V(6); PG8_BAR; PG8_MMA(1, 1, At, B1); PG8_BAR;
            PG8_LDB(B0, 1, 0); PG8_SCHED; PG8_LDA(At, 1, 0); PG8_STAGE(PG8_SA(0, 1), a2 + hstep, voffA);
            PG8_WAIT_L(8); PG8_BAR; PG8_WAIT_L(0); PG8_MMA(0, 0, At, B0); PG8_BAR; PG8_SCHED;
            PG8_LDB(B1, 1, 1); PG8_STAGE(PG8_SB(1, 0), b3, voffB);
            PG8_BAR; PG8_WAIT_L(0); PG8_MMA(0, 1, At, B1); PG8_BAR;
            PG8_LDA(At, 1, 1); PG8_STAGE(PG8_SA(1, 0), a3, voffA);
            PG8_BAR; PG8_WAIT_L(0); PG8_MMA(1, 0, At, B0); PG8_BAR; PG8_SCHED;
            PG8_STAGE(PG8_SB(1, 1), b3 + hstep, voffB);
            PG8_WAIT_V(6); PG8_BAR; PG8_MMA(1, 1, At, B1); PG8_BAR;
            }
        }
        if constexpr (ALIGN_EPI) { if (wr == 0) PG8_BAR; }
        if constexpr (!Epi::AFTER_DRAIN) { E(acc, cur, wr, wc, fr, fq); S.done(cur); }
        if (!has_next) break;
#pragma unroll
        for (int a = 0; a < 2; ++a)
#pragma unroll
            for (int b = 0; b < 2; ++b)
#pragma unroll
                for (int m = 0; m < 4; ++m)
#pragma unroll
                    for (int n = 0; n < 2; ++n) acc[a][b][m][n] = (f32x4){0.f, 0.f, 0.f, 0.f};
        cur = nxt; cA = nA; cB = nB; ++ui;
        if constexpr (ALIGN_EPI) { if (wr == 1) PG8_BAR; }
    }
    PG8_WAIT_V(0);
    if constexpr (!ALIGN_EPI) { if (wr == 0) PG8_BAR; }
    PG8_BAR;
    if constexpr (Epi::AFTER_DRAIN) { E.fused(acc, cur, wr, wc, fr, fq, lds, wid, lane); S.done(cur); }
#undef PG8_SA
#undef PG8_SB
#undef PG8_STAGE
#undef PG8_LDA
#undef PG8_LDB
#undef PG8_MMA
#undef PG8_WAIT_V
#undef PG8_WAIT_L
#undef PG8_BAR
#undef PG8_SCHED
}
}
#include <hip/hip_bf16.h>
#include <cmath>
namespace attn_body {
using bf16=__hip_bfloat16;
using bf16x8=__attribute__((ext_vector_type(8)))short;
using s16x4=__attribute__((ext_vector_type(4)))short;
using f32x16=__attribute__((ext_vector_type(16)))float;
using u32x4=__attribute__((ext_vector_type(4)))unsigned;
constexpr int SEQ=4096,D=64,DM=3072;
constexpr int NW=8,QBLK=32,QB=QBLK*NW,KVBLK=64,NQB=SEQ/QB;
constexpr int ATTN_PITCH=DM, ATTN_UNIT_ROWS=QB;
__device__ __forceinline__ int crow(int r,int hi){return (r&3)+8*(r>>2)+4*hi;}
#define SBAR() __builtin_amdgcn_sched_barrier(0)
__device__ __forceinline__ void cmask(f32x16&p0,f32x16&p1,int jb,int qrel,int hi){
  const float NEG=-INFINITY; int kb=64*jb+4*hi;
  #pragma unroll
  for(int r=0;r<16;++r){int kv=kb+(r&3)+8*(r>>2); if(kv>qrel)p0[r]=NEG; if(kv+32>qrel)p1[r]=NEG;}
}

constexpr int NSLOT=3, SLOTB=8192;
constexpr int LDS_K=0, LDS_V=NSLOT*SLOTB, LDS_WS=2*NSLOT*SLOTB, LDS_OST=LDS_WS+NW*64*4, LDS_BIAS=LDS_OST+NW*4096, LDS_BYTES=LDS_BIAS+SEQ*4;
constexpr float C2=0.125f*1.4426950408889634f;
__device__ __forceinline__ void glds16(const void*gsrc,unsigned lds_dst){unsigned keep;
  asm volatile("s_mov_b32 %0, m0\n\ts_mov_b32 m0, %2\n\ts_nop 0\n\tglobal_load_lds_dwordx4 %1, off\n\ts_mov_b32 m0, %0":"=&s"(keep):"v"(gsrc),"s"(lds_dst):"memory");}
__device__ __forceinline__ float max3f(float a,float b,float c){float r;asm("v_max3_f32 %0, %1, %2, %3":"=v"(r):"v"(a),"v"(b),"v"(c));return r;}
__device__ __forceinline__ float max2f(float a,float b){float r;asm("v_max_f32_e32 %0, %1, %2":"=v"(r):"v"(a),"v"(b));return r;}
__device__ __forceinline__ float fadd_s(float a,float b){float r;asm("v_add_f32_e32 %0, %1, %2":"=v"(r):"v"(a),"v"(b));return r;}
__device__ __forceinline__ float fsub_s(float a,float b){float r;asm("v_sub_f32_e32 %0, %1, %2":"=v"(r):"v"(a),"v"(b));return r;}
typedef float f32x2_t __attribute__((ext_vector_type(2))); typedef __bf16 bf16x2_t __attribute__((ext_vector_type(2)));
__device__ __forceinline__ unsigned cvtpk_s(float lo,float hi){f32x2_t v={lo,hi};bf16x2_t b=__builtin_convertvector(v,bf16x2_t);return __builtin_bit_cast(unsigned,b);}
#define WAIT_BAR(N) asm volatile("s_waitcnt vmcnt(" #N ") lgkmcnt(0)\n\ts_barrier":::"memory")

__device__ __forceinline__ bf16x8 bias_frag(float v,int hi){
  const unsigned h1=cvtpk_s(v,0.f)&0xffffu; const float r1=v-__uint_as_float(h1<<16);
  const unsigned h2=cvtpk_s(r1,0.f)&0xffffu; const float r2=r1-__uint_as_float(h2<<16);
  const unsigned h3=cvtpk_s(r2,0.f)&0xffffu;
  u32x4 w; w.x=hi?0u:(h1|(h2<<16)); w.y=hi?0u:(h3|0x3f800000u); w.z=hi?0u:0x3f803f80u; w.w=0u; return __builtin_bit_cast(bf16x8,w);
}
__device__ __forceinline__ bf16x8 ref_frag(float v){
  const unsigned h1=cvtpk_s(v,0.f)&0xffffu; const float r1=v-__uint_as_float(h1<<16);
  const unsigned h2=cvtpk_s(r1,0.f)&0xffffu; const float r2=r1-__uint_as_float(h2<<16);
  const unsigned h3=cvtpk_s(r2,0.f)&0xffffu;
  u32x4 w; w.x=0x3f803f80u; w.y=0x3f80u|(h1<<16); w.z=h2|(h3<<16); w.w=0u; return __builtin_bit_cast(bf16x8,w);
}
__device__ __forceinline__ void qkt(f32x16&p0,f32x16&p1,const char*Kslot,const bf16x8*qr,bf16x8 qx,int r32,int hi,float bv0,float bv1){
  const char*kb=Kslot+hi*1024+r32*16;
  p0=__builtin_amdgcn_mfma_f32_32x32x16_bf16(bias_frag(bv0,hi),qx,f32x16{},0,0,0);
  p1=__builtin_amdgcn_mfma_f32_32x32x16_bf16(bias_frag(bv1,hi),qx,f32x16{},0,0,0);
  #pragma unroll
  for(int d0=0;d0<4;++d0){
    const bf16x8 b0=*reinterpret_cast<const bf16x8*>(kb+d0*2048);
    const bf16x8 b1=*reinterpret_cast<const bf16x8*>(kb+d0*2048+512);
    p0=__builtin_amdgcn_mfma_f32_32x32x16_bf16(b0,qr[d0],p0,0,0,0);p1=__builtin_amdgcn_mfma_f32_32x32x16_bf16(b1,qr[d0],p1,0,0,0);}
}
typedef __attribute__((address_space(3))) const char* lds_cptr;
typedef short v4i16_t __attribute__((ext_vector_type(4)));
__device__ __forceinline__ void kload8(bf16x8*kf,lds_cptr kp){
  kf[0]=*(const __attribute__((address_space(3))) bf16x8*)(kp);      kf[1]=*(const __attribute__((address_space(3))) bf16x8*)(kp+512);
  kf[2]=*(const __attribute__((address_space(3))) bf16x8*)(kp+2048); kf[3]=*(const __attribute__((address_space(3))) bf16x8*)(kp+2560);
  kf[4]=*(const __attribute__((address_space(3))) bf16x8*)(kp+4096); kf[5]=*(const __attribute__((address_space(3))) bf16x8*)(kp+4608);
  kf[6]=*(const __attribute__((address_space(3))) bf16x8*)(kp+6144); kf[7]=*(const __attribute__((address_space(3))) bf16x8*)(kp+6656);
}
__device__ __forceinline__ void kload2(bf16x8*kf,lds_cptr kp,int j){ kf[2*j]=*(const __attribute__((address_space(3))) bf16x8*)(kp+j*2048); kf[2*j+1]=*(const __attribute__((address_space(3))) bf16x8*)(kp+j*2048+512); }
__device__ __forceinline__ s16x4 vtr(lds_cptr p){ return __builtin_bit_cast(s16x4,__builtin_amdgcn_ds_read_tr16_b64_v4i16((__attribute__((address_space(3))) v4i16_t*)p)); }
__device__ __forceinline__ float rowmax(const f32x16&p0,const f32x16&p1){
  float a=max3f(p0[0],p0[1],p1[0]),b=max3f(p0[2],p0[3],p1[1]);a=max3f(a,p1[2],p1[3]);
  #pragma unroll
  for(int r=4;r<16;r+=4){a=max3f(a,p0[r],p0[r+1]);b=max3f(b,p0[r+2],p0[r+3]);a=max3f(a,p1[r],p1[r+1]);b=max3f(b,p1[r+2],p1[r+3]);}
  const float m=max2f(a,b);
  auto rr=__builtin_amdgcn_permlane32_swap(__float_as_uint(m),__float_as_uint(m),false,false);
  return max2f(__uint_as_float(rr[0]),__uint_as_float(rr[1]));
}
__device__ __forceinline__ void pv(f32x16*o,int vb,bf16x8 pa0,bf16x8 pa1,bf16x8 pa2,bf16x8 pa3){
  #pragma unroll
  for(int d0=0;d0<2;++d0){s16x4 lo[4],hi[4];
    #pragma unroll
    for(int ks=0;ks<4;++ks){
      asm volatile("ds_read_b64_tr_b16 %0,%1 offset:%c2":"=&v"(lo[ks]):"v"(vb),"i"(d0*4096+ks*1024):"memory");
      asm volatile("ds_read_b64_tr_b16 %0,%1 offset:%c2":"=&v"(hi[ks]):"v"(vb),"i"(d0*4096+ks*1024+512):"memory");}
    asm volatile("s_waitcnt lgkmcnt(0)":::"memory");SBAR();
    #define PK(k) (bf16x8){lo[k][0],lo[k][1],lo[k][2],lo[k][3],hi[k][0],hi[k][1],hi[k][2],hi[k][3]}
    o[d0]=__builtin_amdgcn_mfma_f32_32x32x16_bf16(pa0,PK(0),o[d0],0,0,0);
    o[d0]=__builtin_amdgcn_mfma_f32_32x32x16_bf16(pa1,PK(1),o[d0],0,0,0);
    o[d0]=__builtin_amdgcn_mfma_f32_32x32x16_bf16(pa2,PK(2),o[d0],0,0,0);
    o[d0]=__builtin_amdgcn_mfma_f32_32x32x16_bf16(pa3,PK(3),o[d0],0,0,0);
    #undef PK
  }
}

#ifndef ATTN_STORE16
#define ATTN_STORE16(p,v) (*(u32x4*)(p)=(v))
#endif
template<int THRL> __device__ __forceinline__ void attn_unit(long rowbase,int qb,const bf16*Qh,const bf16*__restrict__ Kh0,const bf16*__restrict__ Vh0,bf16*Oh,int OP,const float*__restrict__ btab,float slope2,char*shm){
  const int tid=pg8::otid(),lane=tid&63,r32=lane&31,hi=lane>>5; const int wid=__builtin_amdgcn_readfirstlane(tid>>6);
  const int q0=qb*QB;
  const bf16*Qw=Qh+(rowbase+q0+wid*QBLK)*DM;
  const bf16*Kh=Kh0+rowbase*DM,*Vh=Vh0+rowbase*DM;
  const unsigned lds0=(unsigned)(uintptr_t)shm;
  float*wsf=(float*)(shm+LDS_WS)+wid*64;
  const bf16*ksrc=Kh+(long)lane*DM+wid*8;
  const bf16*vsrc=Vh+(long)(16*(wid&3)+(lane>>2))*DM+(wid>>2)*32+(lane&3)*8;
  const unsigned kdst=lds0+LDS_K+wid*1024, vdst=lds0+LDS_V+wid*1024;
  #define DMA_K(t,slot) glds16(ksrc+(long)(t)*KVBLK*DM,(unsigned)__builtin_amdgcn_readfirstlane(kdst+(slot)))
  #define DMA_V(t,slot) glds16(vsrc+(long)(t)*KVBLK*DM,(unsigned)__builtin_amdgcn_readfirstlane(vdst+(slot)))
  const int vb0=(int)(lds0+LDS_V)+((lane>>4)&1)*32+(lane&3)*8+(4*hi+((lane&15)>>2))*64;
  const char*Kbase=shm+LDS_K; bf16x8 kf[8];
  const lds_cptr shm3=(lds_cptr)shm; const lds_cptr kp0=shm3+LDS_K+hi*1024+r32*16; const lds_cptr vp0=shm3+LDS_V+((lane>>4)&1)*32+(lane&3)*8+(4*hi+((lane&15)>>2))*64;
  const int NT=(q0+QB)/KVBLK;
  typedef __attribute__((address_space(3))) float lds_f32;
  { lds_f32*bw=(lds_f32*)(shm3+LDS_BIAS);
    for(int i=tid;i<NT*KVBLK;i+=NW*64) bw[i]=btab?btab[i]:slope2*(float)i; }
  const lds_f32*bl3=(const lds_f32*)(shm3+LDS_BIAS)+r32;
  DMA_K(0,0);DMA_V(0,0);DMA_K(1,SLOTB);
  bf16x8 qr[4];
  #pragma unroll
  for(int d0=0;d0<4;++d0)qr[d0]=*reinterpret_cast<const bf16x8*>(&Qw[(long)r32*DM+d0*16+hi*8]);
  float mhat=0.f,l_reg=0.f;f32x16 o[2];o[0]=f32x16{};o[1]=f32x16{};bf16x8 qx=ref_frag(0.f);
  const int qrel=wid*QBLK+r32;
  #define CMASK(P0,P1,t) do{int jb_=(t)-(NT-4); if(jb_>=0)cmask(P0,P1,jb_,qrel,hi);}while(0)
  bool resc=false;
  #define START(P0,P1) do{ const float rm=rowmax(P0,P1); resc=false; \
    { const float dl=rm; mhat=fadd_s(mhat,dl); \
      _Pragma("unroll") for(int r=0;r<16;++r){P0[r]=fsub_s(P0[r],dl);P1[r]=fsub_s(P1[r],dl);} \
      qx=ref_frag(-mhat); } \
    _Pragma("unroll") for(int r=0;r<16;++r)P0[r]=__builtin_amdgcn_exp2f(P0[r]); }while(0)
  #define RESC() do{ if(resc){ asm volatile("s_waitcnt lgkmcnt(0)":::"memory"); \
      _Pragma("unroll") for(int d_=0;d_<2;++d_) _Pragma("unroll") for(int r=0;r<16;++r)o[d_][r]*=wsf[crow(r,hi)]; } }while(0)
  f32x16 pA0,pA1,pB0,pB1;
  int sl_prev=0,sl_cur=0,sl_next=SLOTB;
  #define ROT() do{sl_prev=sl_cur;sl_cur=sl_next;sl_next=(sl_next==(NSLOT-1)*SLOTB)?0:sl_next+SLOTB;}while(0)
  DMA_K(2,2*SLOTB);
  WAIT_BAR(3);
  qkt(pA0,pA1,Kbase,qr,qx,r32,hi,bl3[0],bl3[32]);asm volatile("s_nop 15\n\ts_nop 7":"+v"(pA0),"+v"(pA1));CMASK(pA0,pA1,0);
  START(pA0,pA1);
  _Pragma("unroll") for(int r=0;r<16;++r)pA1[r]=__builtin_amdgcn_exp2f(pA1[r]);
  WAIT_BAR(0);
  DMA_K(3,0);DMA_V(1,SLOTB);
  ROT();
  kload8(kf,kp0+sl_cur);
  WAIT_BAR(2);
  s16x4 vlo[8],vhi[8]; u32x4 pw0,pw1,pw2,pw3;
  #define PKW(P,B) cvtpk_s(P[B],P[B+1])
  #define PAF(k) __builtin_bit_cast(bf16x8,pw##k)
  #define VFR(i) (bf16x8){vlo[i][0],vlo[i][1],vlo[i][2],vlo[i][3],vhi[i][0],vhi[i][1],vhi[i][2],vhi[i][3]}
  #define PIN(x) asm volatile("":"+v"(x))
  #define MX3(a,b,c) __builtin_fmaxf(__builtin_fmaxf((a),(b)),(c))
  #define GAPA(MF,A0,A1,A2,A3,W0,W1,PW) do{ MF; sacc+=A0; sacc+=A1; sacc+=A2; sacc+=A3; PIN(sacc); W0; W1; PIN(PW); SBAR(); }while(0)
  #define EX(v) __builtin_amdgcn_exp2f(v)
  #define GAPB(MF,X,B) do{ MF; X[B]=EX(X[B]); X[B+1]=EX(X[B+1]); X[B+2]=EX(X[B+2]); X[B+3]=EX(X[B+3]); PIN(X); SBAR(); }while(0)
  #define VRD(i) do{ vlo[i]=vtr(vp_+(((i)>>2)*4096+((i)&3)*1024)); vhi[i]=vtr(vp_+(((i)>>2)*4096+((i)&3)*1024+512)); }while(0)
  #define KRD(G,j) do{ if(G){ kload2(kf,kp0+sl_next,j); SBAR(); } }while(0)
  #define STEP(C0,C1,P0,P1,t,GK,GV,GL) do{ SBAR(); \
    const lds_cptr vp_=vp0+sl_prev; \
    { const float bv0_=bl3[(t)*KVBLK], bv1_=bl3[(t)*KVBLK+32]; \
      C0=__builtin_amdgcn_mfma_f32_32x32x16_bf16(bias_frag(bv0_,hi),qx,f32x16{},0,0,0); \
      C1=__builtin_amdgcn_mfma_f32_32x32x16_bf16(bias_frag(bv1_,hi),qx,f32x16{},0,0,0); } SBAR(); \
    VRD(0); SBAR(); float sacc=(P0[0]+P0[1]); \
    GAPA(C0=__builtin_amdgcn_mfma_f32_32x32x16_bf16(kf[0],qr[0],C0,0,0,0), P0[2],P0[3],P0[4],P0[5],     pw0[0]=PKW(P0,0), pw0[1]=PKW(P0,2), pw0); \
    VRD(4); SBAR(); GAPA(C1=__builtin_amdgcn_mfma_f32_32x32x16_bf16(kf[1],qr[0],C1,0,0,0), P0[6],P0[7],P0[8],P0[9],     pw0[2]=PKW(P0,4), pw0[3]=PKW(P0,6), pw0); \
    VRD(1); SBAR(); GAPA(C0=__builtin_amdgcn_mfma_f32_32x32x16_bf16(kf[2],qr[1],C0,0,0,0),   P0[10],P0[11],P0[12],P0[13], pw1[0]=PKW(P0,8), pw1[1]=PKW(P0,10), pw1); \
    VRD(5); SBAR(); GAPA(C1=__builtin_amdgcn_mfma_f32_32x32x16_bf16(kf[3],qr[1],C1,0,0,0),   P0[14],P0[15],P1[0],P1[1],   pw1[2]=PKW(P0,12),pw1[3]=PKW(P0,14), pw1); \
    VRD(2); SBAR(); GAPA(C0=__builtin_amdgcn_mfma_f32_32x32x16_bf16(kf[4],qr[2],C0,0,0,0),   P1[2],P1[3],P1[4],P1[5],     pw2[0]=PKW(P1,0), pw2[1]=PKW(P1,2), pw2); \
    VRD(6); SBAR(); GAPA(C1=__builtin_amdgcn_mfma_f32_32x32x16_bf16(kf[5],qr[2],C1,0,0,0),   P1[6],P1[7],P1[8],P1[9],     pw2[2]=PKW(P1,4), pw2[3]=PKW(P1,6), pw2); \
    VRD(3); SBAR(); GAPA(C0=__builtin_amdgcn_mfma_f32_32x32x16_bf16(kf[6],qr[3],C0,0,0,0),   P1[10],P1[11],P1[12],P1[13], pw3[0]=PKW(P1,8), pw3[1]=PKW(P1,10), pw3); \
    VRD(7); SBAR(); GAPA(C1=__builtin_amdgcn_mfma_f32_32x32x16_bf16(kf[7],qr[3],C1,0,0,0),   P1[14],P1[15],0.f,0.f,       pw3[2]=PKW(P1,12),pw3[3]=PKW(P1,14), pw3); \
    l_reg+=sacc; \
    if(GK){DMA_K((t)+3,sl_cur);} if(GV){DMA_V((t)+1,sl_next);} \
    CMASK(C0,C1,t); \
    { float a=MX3(C0[0],C0[1],C1[0]),b=MX3(C0[2],C0[3],C1[1]); a=MX3(a,C1[2],C1[3]); \
      _Pragma("unroll") for(int r=4;r<16;r+=4){a=MX3(a,C0[r],C0[r+1]);b=MX3(b,C0[r+2],C0[r+3]);a=MX3(a,C1[r],C1[r+1]);b=MX3(b,C1[r+2],C1[r+3]);} \
      float rm=__builtin_fmaxf(a,b); { auto rr=__builtin_amdgcn_permlane32_swap(__float_as_uint(rm),__float_as_uint(rm),false,false); rm=__builtin_fmaxf(__uint_as_float(rr[0]),__uint_as_float(rr[1])); } \
      resc=false; \
      if(__builtin_expect(__any(rm>(float)THRL),0)){ const float dl=__builtin_fmaxf(rm,0.f); mhat+=dl; \
        _Pragma("unroll") for(int r=0;r<16;++r){C0[r]-=dl;C1[r]-=dl;} \
        qx=ref_frag(-mhat); \
        const float f=__builtin_amdgcn_exp2f(-dl); l_reg*=f; if(hi==0)wsf[r32]=f; resc=true; } } \
    SBAR(); \
    GAPB(o[0]=__builtin_amdgcn_mfma_f32_32x32x16_bf16(PAF(0),VFR(0),o[0],0,0,0), C0,0); \
    GAPB(o[1]=__builtin_amdgcn_mfma_f32_32x32x16_bf16(PAF(0),VFR(4),o[1],0,0,0), C0,4); \
    KRD(GL,0); GAPB(o[0]=__builtin_amdgcn_mfma_f32_32x32x16_bf16(PAF(1),VFR(1),o[0],0,0,0), C0,8); \
    KRD(GL,1); GAPB(o[1]=__builtin_amdgcn_mfma_f32_32x32x16_bf16(PAF(1),VFR(5),o[1],0,0,0), C0,12); \
    KRD(GL,2); GAPB(o[0]=__builtin_amdgcn_mfma_f32_32x32x16_bf16(PAF(2),VFR(2),o[0],0,0,0), C1,0); \
    KRD(GL,3); GAPB(o[1]=__builtin_amdgcn_mfma_f32_32x32x16_bf16(PAF(2),VFR(6),o[1],0,0,0), C1,4); \
    GAPB(o[0]=__builtin_amdgcn_mfma_f32_32x32x16_bf16(PAF(3),VFR(3),o[0],0,0,0), C1,8); \
    GAPB(o[1]=__builtin_amdgcn_mfma_f32_32x32x16_bf16(PAF(3),VFR(7),o[1],0,0,0), C1,12); \
    }while(0)
  int t=1;
  #undef CMASK
  #define CMASK(P0,P1,t) do{}while(0)
  for(;t+5<NT;t+=2){
    STEP(pB0,pB1,pA0,pA1,t,true,true,true);     WAIT_BAR(2); RESC(); ROT();
    STEP(pA0,pA1,pB0,pB1,t+1,true,true,true);   WAIT_BAR(2); RESC(); ROT();
  }
  #undef CMASK
  #define CMASK(P0,P1,t) do{int jb_=(t)-(NT-4); if(jb_>=0)cmask(P0,P1,jb_,qrel,hi);}while(0)
  #define ENDW(tt) do{ if((tt)+3<NT){WAIT_BAR(2);} else if((tt)+2<NT){WAIT_BAR(1);} else {WAIT_BAR(0);} }while(0)
  for(;t+1<NT;t+=2){
    STEP(pB0,pB1,pA0,pA1,t,(t+3<NT),(t+1<NT),(t+1<NT));       ENDW(t);   RESC(); ROT();
    STEP(pA0,pA1,pB0,pB1,t+1,(t+4<NT),(t+2<NT),(t+2<NT));     ENDW(t+1); RESC(); ROT();
  }
  STEP(pB0,pB1,pA0,pA1,NT-1,false,false,false); RESC();
  { float sacc=pB0[0]+pB0[1]; _Pragma("unroll") for(int r=2;r<16;++r)sacc+=pB0[r]; _Pragma("unroll") for(int r=0;r<16;++r)sacc+=pB1[r]; l_reg+=sacc;
    pw0=(u32x4){PKW(pB0,0),PKW(pB0,2),PKW(pB0,4),PKW(pB0,6)};pw1=(u32x4){PKW(pB0,8),PKW(pB0,10),PKW(pB0,12),PKW(pB0,14)};pw2=(u32x4){PKW(pB1,0),PKW(pB1,2),PKW(pB1,4),PKW(pB1,6)};pw3=(u32x4){PKW(pB1,8),PKW(pB1,10),PKW(pB1,12),PKW(pB1,14)};
    SBAR(); pv(o,vb0+sl_cur,PAF(0),PAF(1),PAF(2),PAF(3)); }
  #undef PKW
  #undef PAF
  #undef VFR
  #undef PIN
  #undef MX3
  #undef GAPA
  #undef GAPB
  #undef EX
  #undef VRD
  #undef KRD
  #undef STEP
  #undef ENDW
  {auto rr=__builtin_amdgcn_permlane32_swap(__float_as_uint(l_reg),__float_as_uint(l_reg),false,false);l_reg=__uint_as_float(rr[0])+__uint_as_float(rr[1]);}
  if(hi==0)wsf[32+r32]=l_reg;asm volatile("s_waitcnt lgkmcnt(0)":::"memory");
  float rli[16];
  #pragma unroll
  for(int r=0;r<16;++r)rli[r]=__builtin_amdgcn_rcpf(wsf[32+crow(r,hi)]);
  bf16*Ow=Oh+(rowbase+q0+wid*QBLK)*(long)OP;
  { bf16*stg=(bf16*)(shm+LDS_OST)+wid*2048;
    #pragma unroll
    for(int r=0;r<16;++r){const int orow=crow(r,hi);
      #pragma unroll
      for(int d0=0;d0<2;++d0)stg[orow*64+d0*32+r32]=__float2bfloat16(o[d0][r]*rli[r]);}
    asm volatile("s_waitcnt lgkmcnt(0)":::"memory");
    #pragma unroll
    for(int i=0;i<4;++i){const int row=i*8+(lane>>3),ch=lane&7; const u32x4 v=*(const u32x4*)(stg+row*64+ch*8); ATTN_STORE16(Ow+(long)row*OP+ch*8,v);} }
  asm volatile("s_waitcnt lgkmcnt(0)\n\ts_barrier":::"memory");
  #undef DMA_K
  #undef DMA_V
  #undef CMASK
  #undef START
  #undef RESC
  #undef ROT
}
constexpr int ATTN_LDS_BYTES=LDS_BYTES;
#undef SBAR
#undef WAIT_BAR
}
namespace cg = cooperative_groups;
constexpr int NWAVES = 8;
#ifndef MK_NL
#define MK_NL 1
#endif
constexpr int N_PHASES = 20;
#ifndef PROBE_DUP
#define PROBE_DUP 0
#endif
constexpr int BATCH = 4, SEQ = 4096, T = BATCH * SEQ, DM_ = 1024, FF = 4096, PLE = 256, ZW = 3072, WIN_LD = 3080, RW = 1280, RNB = 10;
constexpr float NORM_EPS = 1e-6f, SUBLN_EPS = 1e-5f, LOG2E = 1.4426950408889634f;
constexpr size_t MiB = 1u << 20;
constexpr size_t WS_WTS = 1 * MiB, WS_PBF = 29 * MiB, WS_LOGF = 37 * MiB, WS_CTAB = 37 * MiB + 512 * 1024, WS_SA = 38 * MiB, WS_SB = 39 * MiB + 512 * 1024, WS_AR = 41 * MiB;
constexpr size_t W_IN = 0, W_OUT = 6 * MiB, W_RIN = 0, W_RG = 5 * MiB, W_ROUT = 6 * MiB, W_UP = 9 * MiB, W_DOWN = 17 * MiB, W_PROJ = 25 * MiB, W_GATE = 25 * MiB + 512 * 1024;
constexpr size_t A_XA = 0, A_Z = 32 * MiB, A_OBUF = 128 * MiB, A_OD = 160 * MiB, A_EBUF = 160 * MiB, A_ACT = 32 * MiB, A_Y = 32 * MiB, A_XR = 72 * MiB, A_GA = 112 * MiB;
constexpr size_t WS_END = WS_AR + 192 * MiB;
static_assert(WS_END <= 256 * MiB, "d_ws map");
constexpr int RING_BYTES = 131072, LDS_BYTES = 147456;
static_assert(attn_body::ATTN_LDS_BYTES <= RING_BYTES, "attention LDS");

#define GAS __attribute__((address_space(1)))
#define LAS __attribute__((address_space(3)))
typedef unsigned short bf16;
typedef unsigned v4u __attribute__((ext_vector_type(4)));
typedef unsigned v2u __attribute__((ext_vector_type(2)));
typedef float f32x4 __attribute__((ext_vector_type(4)));
typedef short bf16x8 __attribute__((ext_vector_type(8)));
#define LDS_WAIT() asm volatile("s_waitcnt lgkmcnt(0)" ::: "memory")
__device__ __forceinline__ unsigned f2bf(float f) { unsigned u = __builtin_bit_cast(unsigned, f); return (u + 0x7fffu + ((u >> 16) & 1u)) >> 16; }
__device__ __forceinline__ unsigned pk2(float lo, float hi) { return f2bf(lo) | (f2bf(hi) << 16); }
__device__ __forceinline__ float bflo(unsigned w) { return __uint_as_float(w << 16); }
__device__ __forceinline__ float bfhi(unsigned w) { return __uint_as_float(w & 0xffff0000u); }
__device__ __forceinline__ float wave_sum(float v) {
#pragma unroll
    for (int o = 1; o < 64; o <<= 1) v += __shfl_xor(v, o);
    return v;
}
__device__ __forceinline__ float log_sigmoid_f(float v) { return v >= 0.f ? -log1pf(expf(-v)) : v - log1pf(expf(v)); }

typedef GAS unsigned gu32;
#define RLX_AGENT __ATOMIC_RELAXED, __HIP_MEMORY_SCOPE_AGENT
#define XB_TMO      128
#define XB_XCNT(j)  (256  + 64 * (j))
#define XB_XSUB(j)  (1280 + 64 * (j))
#define XB_XGEN(j)  (2304 + 64 * (j))
#define XB_TOP      3328
#define XB_TOPGEN   3392
#define XCD_BAR_WORDS 3456
#define XB_SPIN_CAP (1u << 18)

__device__ __forceinline__ unsigned xb_ld(unsigned* p)              { return __hip_atomic_load(p, __ATOMIC_RELAXED, __HIP_MEMORY_SCOPE_AGENT); }
__device__ __forceinline__ unsigned xb_add(unsigned* p, unsigned v) { return __hip_atomic_fetch_add(p, v, __ATOMIC_RELAXED, __HIP_MEMORY_SCOPE_AGENT); }
__device__ __forceinline__ unsigned xb_xcc_id() { return (unsigned)__builtin_amdgcn_s_getreg((3 << 11) | 20) & 0xFu; }
#define XB_SPIN(cond, bar) do { unsigned _sp = 0; while (cond) { __builtin_amdgcn_s_sleep(1); \
    if ((++_sp & 255u) == 0u) { if (xb_ld(&(bar)[XB_TMO])) break; if (_sp > XB_SPIN_CAP) { atomicAdd(&(bar)[XB_TMO], 1u); break; } } } } while (0)

struct XcdBarrier {
    unsigned* bar; unsigned x;
    volatile LAS unsigned* st;
};

__device__ __forceinline__ XcdBarrier xcd_barrier_post(unsigned* bar, volatile LAS unsigned* st) {
    XcdBarrier b; b.bar = bar; b.x = xb_xcc_id(); b.st = st;
    if (threadIdx.x == 0) (void)xb_add(&bar[XB_XCNT(b.x)], 1u);
    return b;
}
__device__ __forceinline__ void xcd_barrier_complete(unsigned* bar, unsigned x, unsigned& nloc, unsigned& nx) {
    const unsigned G = gridDim.x * gridDim.y * gridDim.z;
    unsigned sum, cnt, mine, sp = 0u;
    for (;;) {
        sum = 0u; cnt = 0u; mine = 0u;
#pragma unroll
        for (unsigned j = 0; j < 16; ++j) { const unsigned c = xb_ld(&bar[XB_XCNT(j)]); sum += c; cnt += (c > 0u) ? 1u : 0u; mine = (j == x) ? c : mine; }
        if (sum == G) break;
        __builtin_amdgcn_s_sleep(1);
        if ((++sp & 255u) == 0u) { if (xb_ld(&bar[XB_TMO])) break; if (sp > XB_SPIN_CAP) { atomicAdd(&bar[XB_TMO], 1u); break; } }
    }
    nloc = mine > 0u ? mine : 1u; nx = cnt > 0u ? cnt : 1u;
}

__device__ __forceinline__ void xcd_barrier(const XcdBarrier& b) {
    asm volatile("s_waitcnt vmcnt(0)" ::: "memory");
    __syncthreads();
    if (threadIdx.x == 0) {
        unsigned* bar = b.bar;
        __builtin_amdgcn_s_waitcnt(0);
        unsigned nloc = b.st[0], nx = b.st[1];
        if (nloc == 0u) { xcd_barrier_complete(bar, b.x, nloc, nx); b.st[0] = nloc; b.st[1] = nx; }
        const unsigned old = xb_add(&bar[XB_XSUB(b.x)], 1u);
        const unsigned gen = old / nloc;
        if (old + 1u == (gen + 1u) * nloc) {
            __builtin_amdgcn_fence(__ATOMIC_RELEASE, "agent");
            asm volatile("s_waitcnt vmcnt(0)" ::: "memory");
            const unsigned og = xb_add(&bar[XB_TOP], 1u);
            const unsigned tg = og / nx;
            if (og + 1u == (tg + 1u) * nx) xb_add(&bar[XB_TOPGEN], 1u);
            else XB_SPIN(xb_ld(&bar[XB_TOPGEN]) == tg, bar);
            __builtin_amdgcn_fence(__ATOMIC_ACQUIRE, "agent");
            xb_add(&bar[XB_XGEN(b.x)], 1u);
            asm volatile("s_waitcnt vmcnt(0)" ::: "memory");
        } else {
            XB_SPIN(xb_ld(&bar[XB_XGEN(b.x)]) == gen, bar);
            __builtin_amdgcn_fence(__ATOMIC_ACQUIRE, "agent");
            asm volatile("s_waitcnt vmcnt(0)" ::: "memory");
        }
    }
    __syncthreads();
}
struct Args { const float* in[28]; float* out; unsigned char* ws; int ph_lo, ph_hi; };
struct Frame {
    LAS unsigned char* lds; int tid, lane, wave, vcu, G;
    float* out; unsigned char* ws;
};
#define FIN(i) (args.in[i])
enum { I_X = 0, I_P, I_LN_MIX_PRE, I_LN_MIX_POST, I_LN_MLP_PRE, I_LN_MLP_POST, I_W_UP, I_W_DOWN, I_PLE_PROJ, I_PLE_NORM, I_PLE_GATE, I_ATT_WIN, I_ATT_BF, I_ATT_WOUT,
       I_LQ1, I_LK1, I_LQ2, I_LK2, I_SUBLN, I_REC_WIN, I_CONV_W, I_CONV_B, I_WX, I_BX, I_WA, I_BA, I_APARAM, I_REC_WOUT };

__device__ __forceinline__ void transpose_item(const float* W, int K, int ldw, int ncols, bf16* WT, int row_off, LAS float* scr, int item, int lane) {
    const int nblk = ncols / 32, kb = item / nblk, nb = item % nblk, k0 = 64 * kb, n0 = 32 * nb;
#pragma unroll 8
    for (int i = 0; i < 32; ++i) { const int kk = 2 * i + (lane >> 5); scr[kk * 33 + (lane & 31)] = W[(size_t)(k0 + kk) * ldw + n0 + (lane & 31)]; }
    LDS_WAIT(); asm volatile("" ::: "memory");
    const int c = lane & 7;
#pragma unroll
    for (int j = 0; j < 4; ++j) { const int n = (lane >> 3) + 8 * j; const LAS float* s = scr + (8 * c) * 33 + n;
        v4u o; o.x = pk2(s[0 * 33], s[1 * 33]); o.y = pk2(s[2 * 33], s[3 * 33]); o.z = pk2(s[4 * 33], s[5 * 33]); o.w = pk2(s[6 * 33], s[7 * 33]);
        *(GAS v4u*)(WT + (size_t)(row_off + n0 + n) * K + k0 + 8 * c) = o; }
    LDS_WAIT(); asm volatile("" ::: "memory");
}
__device__ __forceinline__ void convert_layer(const Args& args, Frame& F, int layer) {
    LAS float* scr = (LAS float*)(F.lds + F.wave * 16384);
    const int gw = F.vcu * NWAVES + F.wave, NGW = F.G * NWAVES;
    bf16* wt = (bf16*)(F.ws + WS_WTS);
    bf16 *Wup = (bf16*)((unsigned char*)wt + W_UP), *Wdown = (bf16*)((unsigned char*)wt + W_DOWN), *Wproj = (bf16*)((unsigned char*)wt + W_PROJ), *Wgate = (bf16*)((unsigned char*)wt + W_GATE);
    const float* wup = FIN(I_W_UP) + (size_t)layer * DM_ * FF; const float* wdown = FIN(I_W_DOWN) + (size_t)layer * FF * DM_;
    const float* wproj = FIN(I_PLE_PROJ) + (size_t)layer * PLE * DM_; const float* wgate = FIN(I_PLE_GATE) + (size_t)layer * DM_ * DM_;
    constexpr int I_UP = (DM_ / 64) * (FF / 32), I_DN = (FF / 64) * (DM_ / 32), I_PJ = (PLE / 64) * (DM_ / 32), I_GT = (DM_ / 64) * (DM_ / 32);
    constexpr int I_COMMON = I_UP + I_DN + I_PJ + I_GT;
    constexpr int I_AIN = (DM_ / 64) * (ZW / 32), I_AOUT = (DM_ / 64) * (DM_ / 32);
    constexpr int I_RIN = (DM_ / 64) * (2 * RW / 32), I_RG1 = (128 / 64) * (128 / 32), I_RG = RNB * I_RG1, I_ROUT = (RW / 64) * (DM_ / 32);
    const int nitems = I_COMMON + (layer == 0 ? I_AIN + I_AOUT : I_RIN + 2 * I_RG + I_ROUT);
    for (int it = gw; it < nitems; it += NGW) {
        int r = it;
        if (r < I_UP) { transpose_item(wup, DM_, FF, FF, Wup, 0, scr, r, F.lane); continue; } r -= I_UP;
        if (r < I_DN) { transpose_item(wdown, FF, DM_, DM_, Wdown, 0, scr, r, F.lane); continue; } r -= I_DN;
        if (r < I_PJ) { transpose_item(wproj, PLE, DM_, DM_, Wproj, 0, scr, r, F.lane); continue; } r -= I_PJ;
        if (r < I_GT) { transpose_item(wgate, DM_, DM_, DM_, Wgate, 0, scr, r, F.lane); continue; } r -= I_GT;
        if (layer == 0) {
            if (r < I_AIN) { transpose_item(FIN(I_ATT_WIN), DM_, WIN_LD, ZW, (bf16*)((unsigned char*)wt + W_IN), 0, scr, r, F.lane); continue; } r -= I_AIN;
            transpose_item(FIN(I_ATT_WOUT), DM_, DM_, DM_, (bf16*)((unsigned char*)wt + W_OUT), 0, scr, r, F.lane);
        } else {
            if (r < I_RIN) { transpose_item(FIN(I_REC_WIN), DM_, 2 * RW, 2 * RW, (bf16*)((unsigned char*)wt + W_RIN), 0, scr, r, F.lane); continue; } r -= I_RIN;
            if (r < I_RG) { const int n = r / I_RG1; transpose_item(FIN(I_WX) + (size_t)n * 128 * 128, 128, 128, 128, (bf16*)((unsigned char*)wt + W_RG) + (size_t)n * 256 * 128, 0, scr, r % I_RG1, F.lane); continue; } r -= I_RG;
            if (r < I_RG) { const int n = r / I_RG1; transpose_item(FIN(I_WA) + (size_t)n * 128 * 128, 128, 128, 128, (bf16*)((unsigned char*)wt + W_RG) + (size_t)n * 256 * 128, 128, scr, r % I_RG1, F.lane); continue; } r -= I_RG;
            transpose_item(FIN(I_REC_WOUT), RW, DM_, DM_, (bf16*)((unsigned char*)wt + W_ROUT), 0, scr, r, F.lane);
        }
    }
    const GAS f32x4* ps = (const GAS f32x4*)(FIN(I_P) + (size_t)layer * T * PLE); GAS v2u* pd = (GAS v2u*)(F.ws + WS_PBF);
    for (int i = blockIdx.x * (NWAVES * 64) + F.tid; i < T * PLE / 4; i += F.G * NWAVES * 64) { const f32x4 v = ps[i]; v2u o; o.x = pk2(v.x, v.y); o.y = pk2(v.z, v.w); pd[i] = o; }
}

__device__ __forceinline__ void ld_row_f32(const float* row, int lane, f32x4 (&v)[4]) { const GAS f32x4* p = (const GAS f32x4*)row + lane;
#pragma unroll
    for (int j = 0; j < 4; ++j) v[j] = p[64 * j]; }
__device__ __forceinline__ void ld_row_bf16(const bf16* row, int lane, f32x4 (&v)[4]) { const GAS v2u* p = (const GAS v2u*)row + lane;
#pragma unroll
    for (int j = 0; j < 4; ++j) { const v2u w = p[64 * j]; v[j] = (f32x4){bflo(w.x), bfhi(w.x), bflo(w.y), bfhi(w.y)}; } }
__device__ __forceinline__ void st_row_f32(float* row, int lane, const f32x4 (&v)[4]) { GAS f32x4* p = (GAS f32x4*)row + lane;
#pragma unroll
    for (int j = 0; j < 4; ++j) p[64 * j] = v[j]; }
__device__ __forceinline__ void st_row_bf16(bf16* row, int lane, const f32x4 (&v)[4]) { GAS v2u* p = (GAS v2u*)row + lane;
#pragma unroll
    for (int j = 0; j < 4; ++j) { v2u o; o.x = pk2(v[j].x, v[j].y); o.y = pk2(v[j].z, v[j].w); p[64 * j] = o; } }
__device__ __forceinline__ float row_rstd(const f32x4 (&v)[4], float eps) { float s = 0.f;
#pragma unroll
    for (int j = 0; j < 4; ++j) s += (v[j].x * v[j].x + v[j].y * v[j].y) + (v[j].z * v[j].z + v[j].w * v[j].w);
    return 1.0f / sqrtf(wave_sum(s) * (1.0f / 1024.0f) + eps); }

__device__ __forceinline__ void rowpass_pre0(const Args& args, Frame& F) {
    LAS float* fzw = (LAS float*)F.lds;
    const float* win = FIN(I_ATT_WIN);
    for (int i = F.tid; i < 8192; i += NWAVES * 64) { const int k = i >> 3, jj = i & 7; fzw[jj * 1024 + k] = win[(size_t)k * WIN_LD + ZW + jj]; }
    __syncthreads();
    const int gw = F.vcu * NWAVES + F.wave, NGW = F.G * NWAVES;
    bf16* XA = (bf16*)(F.ws + WS_AR + A_XA); float* logf = (float*)(F.ws + WS_LOGF);
    f32x4 g[4]; ld_row_f32(FIN(I_LN_MIX_PRE), F.lane, g);
    const float bfj = FIN(I_ATT_BF)[F.lane & 7];
    for (int m = gw; m < T; m += NGW) {
        f32x4 v[4]; ld_row_f32(FIN(I_X) + (size_t)m * DM_, F.lane, v);
        const float r = row_rstd(v, NORM_EPS);
#pragma unroll
        for (int j = 0; j < 4; ++j) v[j] = v[j] * r * g[j];
        st_row_bf16(XA + (size_t)m * DM_, F.lane, v);
        float mine = 0.f;
#pragma unroll
        for (int jj = 0; jj < 8; ++jj) { float d = 0.f;
#pragma unroll
            for (int j = 0; j < 4; ++j) { const f32x4 w = *(const LAS f32x4*)(fzw + jj * 1024 + 256 * j + 4 * F.lane); d += (v[j].x * w.x + v[j].y * w.y) + (v[j].z * w.z + v[j].w * w.w); }
            d = wave_sum(d); if ((F.lane & 7) == jj) mine = d; }
        if (F.lane < 8) logf[(size_t)m * 8 + F.lane] = log_sigmoid_f(mine + bfj);
    }
}
template <bool HAS_M, bool NORM_OUT, bool HAS_E>
__device__ __forceinline__ void rowpass(Frame& F, const float* hsrc, float* hdst, const float* gpost, const float* gpre, const float* ge) {
    const int gw = F.vcu * NWAVES + F.wave, NGW = F.G * NWAVES;
    bf16* XA = (bf16*)(F.ws + WS_AR + A_XA); bf16* EB = (bf16*)(F.ws + WS_AR + A_EBUF);
    for (int m = gw; m < T; m += NGW) {
        f32x4 h[4]; ld_row_f32(hsrc + (size_t)m * DM_, F.lane, h);
        if (HAS_M) { f32x4 mm[4]; ld_row_bf16(XA + (size_t)m * DM_, F.lane, mm); const float r = row_rstd(mm, NORM_EPS); f32x4 g[4]; ld_row_f32(gpost, F.lane, g);
#pragma unroll
            for (int j = 0; j < 4; ++j) h[j] = h[j] + mm[j] * r * g[j];
            st_row_f32(hdst + (size_t)m * DM_, F.lane, h); }
        if (NORM_OUT) { const float r = row_rstd(h, NORM_EPS); f32x4 g[4]; ld_row_f32(gpre, F.lane, g);
#pragma unroll
            for (int j = 0; j < 4; ++j) h[j] = h[j] * r * g[j]; }
        st_row_bf16(XA + (size_t)m * DM_, F.lane, h);
        if (HAS_E) { f32x4 e[4]; ld_row_bf16(EB + (size_t)m * DM_, F.lane, e); const float r = row_rstd(e, NORM_EPS); f32x4 g[4]; ld_row_f32(ge, F.lane, g);
#pragma unroll
            for (int j = 0; j < 4; ++j) e[j] = e[j] * r * g[j];
            st_row_bf16(EB + (size_t)m * DM_, F.lane, e); }
    }
}
__device__ __forceinline__ void cumsum_phase(Frame& F) {
    LAS float* sm = (LAS float*)F.lds;
    const float* logf = (const float*)(F.ws + WS_LOGF); float* ctab = (float*)(F.ws + WS_CTAB);
    for (int s = blockIdx.x; s < BATCH * 8; s += F.G) {
        const int b = s >> 3, h = s & 7; float v[8]; float run = 0.f;
#pragma unroll
        for (int i = 0; i < 8; ++i) { run += logf[((size_t)b * SEQ + F.tid * 8 + i) * 8 + h]; v[i] = run; }
        float incl = run;
#pragma unroll
        for (int o = 1; o < 64; o <<= 1) { const float y = __shfl_up(incl, o); if (F.lane >= o) incl += y; }
        if (F.lane == 63) sm[F.wave] = incl;
        __syncthreads();
        float woff = 0.f;
        for (int w = 0; w < F.wave; ++w) woff += sm[w];
        const float excl = woff + incl - run;
#pragma unroll
        for (int i = 0; i < 8; ++i) ctab[(size_t)s * SEQ + F.tid * 8 + i] = -(excl + v[i]) * LOG2E;
        __syncthreads();
    }
}
__device__ __forceinline__ void diff_combine(const Args& args, Frame& F) {
    const int gw = F.vcu * NWAVES + F.wave, NGW = F.G * NWAVES;
    const bf16* O0 = (const bf16*)(F.ws + WS_AR + A_OD); const bf16* O1 = O0 + (size_t)T * 512; bf16* OB = (bf16*)(F.ws + WS_AR + A_OBUF);
    const float s1 = wave_sum(FIN(I_LQ1)[F.lane] * FIN(I_LK1)[F.lane]), s2 = wave_sum(FIN(I_LQ2)[F.lane] * FIN(I_LK2)[F.lane]);
    const float lam_init = 0.8f - 0.6f * 1.0f;
    const float lam = expf(s1) - expf(s2) + lam_init, post = 1.0f - lam_init;
    float sg[8];
#pragma unroll
    for (int e = 0; e < 8; ++e) sg[e] = FIN(I_SUBLN)[(F.lane & 15) * 8 + e] * post;
    for (int m = gw; m < T; m += NGW) {
        const v4u a = *(const GAS v4u*)(O0 + (size_t)m * 512 + F.lane * 8), b = *(const GAS v4u*)(O1 + (size_t)m * 512 + F.lane * 8);
        float d[8];
        d[0] = bflo(a.x) - lam * bflo(b.x); d[1] = bfhi(a.x) - lam * bfhi(b.x); d[2] = bflo(a.y) - lam * bflo(b.y); d[3] = bfhi(a.y) - lam * bfhi(b.y);
        d[4] = bflo(a.z) - lam * bflo(b.z); d[5] = bfhi(a.z) - lam * bfhi(b.z); d[6] = bflo(a.w) - lam * bflo(b.w); d[7] = bfhi(a.w) - lam * bfhi(b.w);
        float ss = 0.f;
#pragma unroll
        for (int e = 0; e < 8; ++e) ss += d[e] * d[e];
        ss += __shfl_xor(ss, 1); ss += __shfl_xor(ss, 2); ss += __shfl_xor(ss, 4); ss += __shfl_xor(ss, 8);
        const float r = 1.0f / sqrtf(ss * (1.0f / 128.0f) + SUBLN_EPS);
        v4u o; o.x = pk2(d[0] * r * sg[0], d[1] * r * sg[1]); o.y = pk2(d[2] * r * sg[2], d[3] * r * sg[3]); o.z = pk2(d[4] * r * sg[4], d[5] * r * sg[5]); o.w = pk2(d[6] * r * sg[6], d[7] * r * sg[7]);
        *(GAS v4u*)(OB + (size_t)m * DM_ + F.lane * 8) = o;
    }
}
__device__ __forceinline__ void attention_phase(Frame& F, char* lds) {
    using abf = attn_body::bf16;
    const abf* Z = (const abf*)(F.ws + WS_AR + A_Z); abf* OB = (abf*)(F.ws + WS_AR + A_OBUF); abf* OD = (abf*)(F.ws + WS_AR + A_OD);
    const float* ctab = (const float*)(F.ws + WS_CTAB);
    for (int it = 0; ; ++it) {
        const int p = F.vcu + (it >> 1) * F.G; if (p >= BATCH * 24 * 8) break;
        const int bvh = p >> 3, s = p & 7, b = bvh / 24, vh = bvh % 24;
        const abf *Qh, *Kh, *Vh; abf* Oh; int OP; const float* btab; float slope2;
        if (vh < 16) { const int h = vh >> 2, mcomp = (vh >> 1) & 1, vhalf = vh & 1;
            Qh = Z + h * 128 + mcomp * 64; Kh = Z + 512 + h * 128 + mcomp * 64; Vh = Z + 1024 + h * 128 + vhalf * 64;
            Oh = OD + (size_t)mcomp * T * 512 + h * 128 + vhalf * 64; OP = 512; btab = nullptr; slope2 = exp2f(-2.0f * (float)(h + 1)) * LOG2E;
        } else { const int h = vh - 16;
            Qh = Z + 1536 + h * 64; Kh = Z + 2048 + h * 64; Vh = Z + 2560 + h * 64; Oh = OB + 512 + h * 64; OP = DM_; btab = ctab + (size_t)(b * 8 + h) * SEQ; slope2 = 0.f; }
        attn_body::attn_unit<8>((long)b * SEQ, (it & 1) ? 15 - s : s, Qh, Kh, Vh, Oh, OP, btab, slope2, lds);
    }
}
template <bool FINAL>
__device__ __forceinline__ void rec_core(const Args& args, Frame& F) {
    LAS bf16* xcb = (LAS bf16*)(F.lds);
    LAS float* xcf = (LAS float*)(F.lds + 17408);
    LAS bf16* hst = (LAS bf16*)(F.lds + 17408 + 33792);
    const bf16* XR = (const bf16*)(F.ws + WS_AR + A_XR); const bf16* YB = (const bf16*)(F.ws + WS_AR + A_Y); bf16* GA = (bf16*)(F.ws + WS_AR + A_GA);
    const bf16* WG = (const bf16*)(F.ws + WS_WTS + W_RG);
    float* SA = (float*)(F.ws + WS_SA); float* SB = (float*)(F.ws + WS_SB);
    const float *cw = FIN(I_CONV_W), *cb = FIN(I_CONV_B);
    const int tid = F.tid, lane = F.lane, w = F.wave, fr = lane & 15, fq = lane >> 4;
    for (int it = blockIdx.x; it < BATCH * 64 * RNB; it += F.G) {
        const int n = it % RNB, k = (it / RNB) % 64, b = it / (RNB * 64);
        const size_t trow0 = (size_t)b * SEQ + (size_t)k * 64;
#pragma unroll
        for (int q = 0; q < 2; ++q) {
            const int idx = tid + q * 512, r = idx >> 4, cgp = idx & 15, c0 = n * 128 + cgp * 8;
            f32x4 a0 = *(const GAS f32x4*)(cb + c0), a1 = *(const GAS f32x4*)(cb + c0 + 4);
#pragma unroll
            for (int j = 0; j < 4; ++j) { const int tt = k * 64 + r - 3 + j;
                if (tt >= 0) { const v4u xv = *(const GAS v4u*)(XR + ((size_t)b * SEQ + tt) * RW + c0);
                    const f32x4 w0 = *(const GAS f32x4*)(cw + j * RW + c0), w1 = *(const GAS f32x4*)(cw + j * RW + c0 + 4);
                    a0[0] += w0[0] * bflo(xv.x); a0[1] += w0[1] * bfhi(xv.x); a0[2] += w0[2] * bflo(xv.y); a0[3] += w0[3] * bfhi(xv.y);
                    a1[0] += w1[0] * bflo(xv.z); a1[1] += w1[1] * bfhi(xv.z); a1[2] += w1[2] * bflo(xv.w); a1[3] += w1[3] * bfhi(xv.w); } }
            *(LAS f32x4*)(xcf + r * 132 + cgp * 8) = a0; *(LAS f32x4*)(xcf + r * 132 + cgp * 8 + 4) = a1;
            v4u o; o.x = pk2(a0[0], a0[1]); o.y = pk2(a0[2], a0[3]); o.z = pk2(a1[0], a1[1]); o.w = pk2(a1[2], a1[3]);
            *(LAS v4u*)(xcb + r * 136 + cgp * 8) = o;
        }
        __syncthreads();
        f32x4 ax[4], aa[4];
#pragma unroll
        for (int mt = 0; mt < 4; ++mt) { ax[mt] = (f32x4){0.f, 0.f, 0.f, 0.f}; aa[mt] = (f32x4){0.f, 0.f, 0.f, 0.f}; }
        const bf16* Bx = WG + ((size_t)n * 256 + 16 * w + fr) * 128 + 8 * fq; const bf16* Ba = Bx + 128 * 128;
#pragma unroll
        for (int kk = 0; kk < 4; ++kk) { const bf16x8 bx = *(const GAS bf16x8*)(Bx + 32 * kk), ba = *(const GAS bf16x8*)(Ba + 32 * kk);
#pragma unroll
            for (int mt = 0; mt < 4; ++mt) { const bf16x8 af = *(const LAS bf16x8*)(xcb + (16 * mt + fr) * 136 + 32 * kk + 8 * fq);
                ax[mt] = __builtin_amdgcn_mfma_f32_16x16x32_bf16(af, bx, ax[mt], 0, 0, 0); aa[mt] = __builtin_amdgcn_mfma_f32_16x16x32_bf16(af, ba, aa[mt], 0, 0, 0); } }
        const int cl = 16 * w + fr, c = n * 128 + cl;
        const float bxv = FIN(I_BX)[c], bav = FIN(I_BA)[c], ls8 = 8.0f * log_sigmoid_f(FIN(I_APARAM)[c]);
        float Hin = 0.f, Ac = 1.f, Bc = 0.f;
        if (FINAL) {
            float sa[16], sb[16];
#pragma unroll
            for (int j = 0; j < 16; ++j) { const int jc = 16 * fq + j; const size_t o = ((size_t)b * 64 + jc) * RW + c; const bool ok = jc < k; sa[j] = ok ? SA[o] : 1.f; sb[j] = ok ? SB[o] : 0.f; }
            float A = 1.f, B = 0.f;
#pragma unroll
            for (int j = 0; j < 16; ++j) { B = sa[j] * B + sb[j]; A = A * sa[j]; }
            { const float A1 = __shfl_up(A, 16), B1 = __shfl_up(B, 16); if (fq >= 1) { B = A * B1 + B; A = A1 * A; } }
            { const float A2 = __shfl_up(A, 32), B2 = __shfl_up(B, 32); if (fq >= 2) { B = A * B2 + B; A = A2 * A; } }
            Hin = __shfl(B, fr + 48);
        }
#pragma unroll
        for (int mt = 0; mt < 4; ++mt) {
            float cA[4], hl[4];
#pragma unroll
            for (int i = 0; i < 4; ++i) { const int tl = 16 * mt + 4 * fq + i;
                const float gx = 1.0f / (1.0f + expf(-(ax[mt][i] + bxv))), ga = 1.0f / (1.0f + expf(-(aa[mt][i] + bav)));
                const float la = ls8 * ga, a = expf(la); float mult = sqrtf(-expm1f(2.0f * la)); if (k == 0 && tl == 0) mult = 1.0f;
                const float bb = mult * gx * xcf[tl * 132 + cl];
                if (i == 0) { cA[0] = a; hl[0] = bb; } else { cA[i] = cA[i - 1] * a; hl[i] = a * hl[i - 1] + bb; } }
            float A = cA[3], B = hl[3];
            { const float A1 = __shfl_up(A, 16), B1 = __shfl_up(B, 16); if (fq >= 1) { B = A * B1 + B; A = A1 * A; } }
            { const float A2 = __shfl_up(A, 32), B2 = __shfl_up(B, 32); if (fq >= 2) { B = A * B2 + B; A = A2 * A; } }
            float Ae = __shfl_up(A, 16), Be = __shfl_up(B, 16); if (fq == 0) { Ae = 1.f; Be = 0.f; }
            const float At = __shfl(A, fr + 48), Bt = __shfl(B, fr + 48);
            if (FINAL) { const float hen = Ae * Hin + Be;
#pragma unroll
                for (int i = 0; i < 4; ++i) { const float hv = cA[i] * hen + hl[i]; hst[(16 * mt + 4 * fq + i) * 136 + cl] = (bf16)f2bf(hv); }
                Hin = At * Hin + Bt;
            } else { Bc = At * Bc + Bt; Ac = Ac * At; }
        }
        if (!FINAL) { if (fq == 0) { const size_t o = ((size_t)b * 64 + k) * RW + c; SA[o] = Ac; SB[o] = Bc; } __syncthreads(); }
        else {
            __syncthreads();
#pragma unroll
            for (int q = 0; q < 2; ++q) { const int idx = tid + q * 512, r = idx >> 4, cgp = idx & 15; const size_t go = (trow0 + r) * RW + n * 128 + cgp * 8;
                const v4u hv = *(const LAS v4u*)(hst + r * 136 + cgp * 8); const v4u yv = *(const GAS v4u*)(YB + go);
                v4u o; o.x = pk2(bflo(hv.x) * bflo(yv.x), bfhi(hv.x) * bfhi(yv.x)); o.y = pk2(bflo(hv.y) * bflo(yv.y), bfhi(hv.y) * bfhi(yv.y));
                o.z = pk2(bflo(hv.z) * bflo(yv.z), bfhi(hv.z) * bfhi(yv.z)); o.w = pk2(bflo(hv.w) * bflo(yv.w), bfhi(hv.w) * bfhi(yv.w));
                *(GAS v4u*)(GA + go) = o; }
        }
    }
}

template <int MODE> __device__ __forceinline__ void run_gemm(Frame& F, const bf16* A, const bf16* Bt, int N, int K, const pg8::EpiX<MODE>& E) {
    pg8::Gemm g{A, Bt, T, N, K}; pg8::StaticOrder S; S.init(T, N, F.G, (int)blockIdx.x);
    pg8::gemm_phase<pg8::EpiX<MODE>, pg8::StaticOrder, true, true>(F.lds, g, S, E);
}
__global__ void __launch_bounds__(NWAVES * 64, 2) fwd_mega(Args args) {
    extern __shared__ __attribute__((aligned(16))) unsigned char lds[];
    Frame F;
    F.lds = (LAS unsigned char*)lds; F.tid = threadIdx.x; F.lane = F.tid & 63; F.wave = __builtin_amdgcn_readfirstlane(F.tid >> 6);
#define PHASE_BEGIN() do { F.tid = pg8::otid(); F.lane = F.tid & 63; F.wave = __builtin_amdgcn_readfirstlane(F.tid >> 6); } while (0)
    F.G = gridDim.x; { const int bx = blockIdx.x; F.vcu = (F.G % 8 == 0) ? (bx % 8) * (F.G / 8) + bx / 8 : bx; }
#pragma unroll
    for (int i = 0; i < 28; ++i) FIN(i) = args.in[i];
    F.out = args.out; F.ws = args.ws;
    const int lo = args.ph_lo, hi = args.ph_hi;
    volatile LAS unsigned* MISC = (volatile LAS unsigned*)(F.lds + RING_BYTES);
    unsigned* barw = (unsigned*)(args.ws + 16384);
    if (F.tid < 64) MISC[F.tid] = 0u;
    if (blockIdx.x == 0) { for (int i = F.tid; i < XCD_BAR_WORDS; i += NWAVES * 64) __hip_atomic_store(barw + i, 0u, RLX_AGENT); }
    __syncthreads();
    XcdBarrier bar; bar.bar = barw; bar.x = 0; bar.st = nullptr;
#if PROBE_DUP & 4
    for (int i_ = 0; i_ < 20; ++i_) cg::this_grid().sync();
#endif
#ifndef PH_MASK
#define PH_MASK 0xFFFFFu
#endif
#define IN(k) (((PH_MASK >> (k)) & 1u) && lo <= (k) && (k) < hi)
#if MK_NL == 1
#define SEAM(k) do { if (IN(k) && IN((k) + 1)) { if ((k) == 0) { cg::this_grid().sync(); bar = xcd_barrier_post(barw, MISC + 8); } else xcd_barrier(bar); } } while (0)
#else
#define SEAM(k) do { } while (0)
#endif
    unsigned char* ws = args.ws; unsigned char* wt = ws + WS_WTS; unsigned char* ar = ws + WS_AR;
    bf16* XA = (bf16*)(ar + A_XA); bf16* EB = (bf16*)(ar + A_EBUF); const bf16* PBF = (const bf16*)(ws + WS_PBF);

    for (int layer = 0; layer < 2; ++layer) {
        const int pb = layer * 10;
        const float* g_mix_post = FIN(I_LN_MIX_POST) + layer * DM_; const float* g_mlp_pre = FIN(I_LN_MLP_PRE) + layer * DM_;
        const float* g_mlp_post = FIN(I_LN_MLP_POST) + layer * DM_; const float* g_ple = FIN(I_PLE_NORM) + layer * DM_;
        if (layer == 0) {
            if (IN(0)) { PHASE_BEGIN(); convert_layer(args, F, 0); __syncthreads(); rowpass_pre0(args, F); } SEAM(0);
            if (IN(1)) { PHASE_BEGIN(); cumsum_phase(F); __syncthreads();
                pg8::EpiX<0> E{(bf16*)(ar + A_Z), ZW, attn_body::C2, 0xC3u, nullptr, nullptr, nullptr}; run_gemm<0>(F, XA, (const bf16*)(wt + W_IN), ZW, DM_, E); } SEAM(1);
            if (IN(2)) { PHASE_BEGIN(); attention_phase(F, (char*)lds);
#if PROBE_DUP & 1
                cg::this_grid().sync(); PHASE_BEGIN(); attention_phase(F, (char*)lds);
#endif
            } SEAM(2);
            if (IN(3)) { PHASE_BEGIN(); diff_combine(args, F); } SEAM(3);
            if (IN(4)) { PHASE_BEGIN(); { pg8::EpiX<0> E{XA, DM_, 1.f, 0u, nullptr, nullptr, nullptr}; run_gemm<0>(F, (const bf16*)(ar + A_OBUF), (const bf16*)(wt + W_OUT), DM_, DM_, E); }
                         { pg8::EpiX<0> E{EB, DM_, 1.f, 0u, nullptr, nullptr, nullptr}; run_gemm<0>(F, PBF, (const bf16*)(wt + W_PROJ), DM_, PLE, E); } } SEAM(4);
        } else {
            if (IN(10)) { PHASE_BEGIN(); convert_layer(args, F, 1); rowpass<false, true, false>(F, F.out, nullptr, nullptr, FIN(I_LN_MIX_PRE) + DM_, nullptr); } SEAM(10);
            if (IN(11)) { PHASE_BEGIN(); pg8::EpiX<2> E{(bf16*)(ar + A_Y), RW, 1.f, 0u, (bf16*)(ar + A_XR), nullptr, nullptr}; run_gemm<2>(F, XA, (const bf16*)(wt + W_RIN), 2 * RW, DM_, E); } SEAM(11);
            if (IN(12)) { PHASE_BEGIN(); rec_core<false>(args, F);
#if PROBE_DUP & 2
                cg::this_grid().sync(); PHASE_BEGIN(); rec_core<false>(args, F);
#endif
            } SEAM(12);
            if (IN(13)) { PHASE_BEGIN(); rec_core<true>(args, F);
#if PROBE_DUP & 2
                cg::this_grid().sync(); PHASE_BEGIN(); rec_core<true>(args, F);
#endif
            } SEAM(13);
            if (IN(14)) { PHASE_BEGIN(); { pg8::EpiX<0> E{XA, DM_, 1.f, 0u, nullptr, nullptr, nullptr}; run_gemm<0>(F, (const bf16*)(ar + A_GA), (const bf16*)(wt + W_ROUT), DM_, RW, E); }
                          { pg8::EpiX<0> E{EB, DM_, 1.f, 0u, nullptr, nullptr, nullptr}; run_gemm<0>(F, PBF, (const bf16*)(wt + W_PROJ), DM_, PLE, E); } } SEAM(14);
        }
        if (IN(pb + 5)) { PHASE_BEGIN(); rowpass<true, true, true>(F, layer == 0 ? FIN(I_X) : (const float*)F.out, F.out, g_mix_post, g_mlp_pre, g_ple); } SEAM(pb + 5);
        if (IN(pb + 6)) { PHASE_BEGIN(); pg8::EpiX<1> E{(bf16*)(ar + A_ACT), FF, 1.f, 0u, nullptr, nullptr, nullptr}; run_gemm<1>(F, XA, (const bf16*)(wt + W_UP), FF, DM_, E); } SEAM(pb + 6);
        if (IN(pb + 7)) { PHASE_BEGIN(); pg8::EpiX<0> E{XA, DM_, 1.f, 0u, nullptr, nullptr, nullptr}; run_gemm<0>(F, (const bf16*)(ar + A_ACT), (const bf16*)(wt + W_DOWN), DM_, FF, E); } SEAM(pb + 7);
        if (IN(pb + 8)) { PHASE_BEGIN(); rowpass<true, false, false>(F, F.out, F.out, g_mlp_post, nullptr, nullptr); } SEAM(pb + 8);
        if (IN(pb + 9)) { PHASE_BEGIN(); pg8::EpiX<3> E{nullptr, DM_, 1.f, 0u, nullptr, F.out, EB}; run_gemm<3>(F, XA, (const bf16*)(wt + W_GATE), DM_, DM_, E); } SEAM(pb + 9);
    }
#undef IN
#undef SEAM
}

extern "C" void kernel_launch(void* const* d_in, const int* in_sizes, int n_in, void* d_out, int out_size, void* d_ws, size_t ws_size, hipStream_t stream) {
    static int grid = 0;
    if (grid == 0) {
        if (n_in != 28 || out_size != T * DM_ || ws_size < WS_END) { fprintf(stderr, "kernel_launch: unexpected shapes: n_in %d out %d ws %zu\n", n_in, out_size, ws_size); grid = -1; return; }
        int dev = 0, cus = 0, per_cu = 0;
        if (hipGetDevice(&dev) != hipSuccess || hipDeviceGetAttribute(&cus, hipDeviceAttributeMultiprocessorCount, dev) != hipSuccess) { grid = -1; return; }
        if (hipFuncSetAttribute((const void*)fwd_mega, hipFuncAttributeMaxDynamicSharedMemorySize, LDS_BYTES) != hipSuccess) { fprintf(stderr, "kernel_launch: hipFuncSetAttribute failed\n"); grid = -1; return; }
        if (hipOccupancyMaxActiveBlocksPerMultiprocessor(&per_cu, (const void*)fwd_mega, NWAVES * 64, LDS_BYTES) != hipSuccess || per_cu < 1) { fprintf(stderr, "kernel_launch: occupancy query says %d\n", per_cu); per_cu = 1; }
        (void)hipGetLastError();
        grid = cus * 1;
        fprintf(stderr, "kernel_launch: grid %d (cus %d, per_cu %d)\n", grid, cus, per_cu);
    }
    if (grid < 0) return;
    Args a{};
    for (int i = 0; i < 28; ++i) a.in[i] = (const float*)d_in[i];
    a.out = (float*)d_out; a.ws = (unsigned char*)d_ws;
#if MK_NL == 1
    a.ph_lo = 0; a.ph_hi = N_PHASES;
    void* kargs[] = {(void*)&a};
    hipError_t e = hipLaunchCooperativeKernel((const void*)fwd_mega, dim3(grid), dim3(NWAVES * 64), kargs, LDS_BYTES, stream);
    if (e != hipSuccess) fprintf(stderr, "kernel_launch: cooperative launch failed: %s (grid %d)\n", hipGetErrorString(e), grid);
#else
    for (int ph = 0; ph < N_PHASES; ++ph) { a.ph_lo = ph; a.ph_hi = ph + 1; hipLaunchKernelGGL(fwd_mega, dim3(grid), dim3(NWAVES * 64), LDS_BYTES, stream, a); }
#endif
}
```
